# Optimizing an MI355X kernel written in HIP

```python
import numpy as np
import jax, jax.numpy as jnp
from jax import lax

D_MODEL = 1024
BATCH = 2
SEQ = 8192
DEPTH = 1

GRID_W = 64
D_MIX = D_MODEL
D_ATT = D_MIX // 2
D_HG = D_MIX - D_ATT
ATT_HEADS = 8
ATT_HEAD_DIM = D_ATT // ATT_HEADS
HG_HEADS = 4
HG_HEAD_DIM = D_HG // HG_HEADS
WIN_ROWS_MAX = 8
WIN_COLS = 16
Q_BLOCK_W = 16
K_BLOCK_W = 32
HG_CHUNK = 64
IN_WIDTHS = (D_ATT, D_ATT, D_ATT, D_ATT, D_HG, D_HG, D_HG, D_HG, D_HG)
D_IN = sum(IN_WIDTHS)
LN_EPS = 1e-5
RMS_EPS = 1e-6
DEEPNORM_ALPHA = (2.0 * DEPTH) ** 0.25
DEEPNORM_BETA = (8.0 * DEPTH) ** -0.25

kernel_name = "hymba_natten_hgrn2_deepnorm_encoder"


def neighbourhood_attention(q, k, v, rpb):
    B, T, H, dh = q.shape
    rows = T // GRID_W
    kr = min(WIN_ROWS_MAX, rows)
    q = q.reshape(B, rows, GRID_W, H, dh)
    k = k.reshape(B, rows, GRID_W, H, dh)
    v = v.reshape(B, rows, GRID_W, H, dh)
    r = np.arange(rows)
    row_start = np.clip(r - kr // 2, 0, rows - kr)
    row_idx = row_start[:, None] + np.arange(kr)[None, :]
    dr = row_idx - r[:, None] + (WIN_ROWS_MAX - 1)
    k_rows = k[:, row_idx]
    v_rows = v[:, row_idx]
    scale = dh ** -0.5
    outs = []
    for j in range(GRID_W // Q_BLOCK_W):
        qc = np.arange(j * Q_BLOCK_W, (j + 1) * Q_BLOCK_W)
        kc0 = int(np.clip(j * Q_BLOCK_W - WIN_COLS // 2, 0, GRID_W - K_BLOCK_W))
        kc = np.arange(kc0, kc0 + K_BLOCK_W)
        col_start = np.clip(qc - WIN_COLS // 2, 0, GRID_W - WIN_COLS)
        in_win = (kc[None, :] >= col_start[:, None]) & (kc[None, :] < col_start[:, None] + WIN_COLS)
        dc = np.clip(kc[None, :] - qc[:, None], -(WIN_COLS - 1), WIN_COLS - 1) + (WIN_COLS - 1)
        q_blk = q[:, :, j * Q_BLOCK_W:(j + 1) * Q_BLOCK_W]
        k_blk = k_rows[:, :, :, kc0:kc0 + K_BLOCK_W]
        v_blk = v_rows[:, :, :, kc0:kc0 + K_BLOCK_W]
        s = jnp.einsum('brqhd,brakhd->bhrqak', q_blk, k_blk,
                       preferred_element_type=jnp.float32) * scale
        bias = rpb[:, dr[:, None, :, None], dc[None, :, None, :]]
        s = jnp.where(in_win[None, None, None, :, None, :], s + bias[None].astype(jnp.float32), -jnp.inf)
        p = jax.nn.softmax(s.reshape(B, H, rows, Q_BLOCK_W, kr * K_BLOCK_W), axis=-1)
        p = p.reshape(B, H, rows, Q_BLOCK_W, kr, K_BLOCK_W).astype(v.dtype)
        outs.append(jnp.einsum('bhrqak,brakhd->brqhd', p, v_blk))
    o = jnp.concatenate(outs, axis=2)
    return o.reshape(B, T, H * dh)


def hgrn2_chunk_scan(q, k, v, log_f):
    B, H, T, dk = q.shape
    dv = v.shape[-1]
    n = T // HG_CHUNK
    causal = np.tril(np.ones((HG_CHUNK, HG_CHUNK), dtype=bool))

    def to_chunks(a):
        return jnp.moveaxis(a.reshape(B, H, n, HG_CHUNK, a.shape[-1]), 2, 0)

    def step(S, inp):
        qc, kc, vc, gc = inp
        b = jnp.cumsum(gc, axis=2)
        b_last = b[:, :, -1:, :]
        o_inter = jnp.einsum('bhtd,bhde->bhte', qc * jnp.exp(b), S)
        diff = jnp.where(causal[:, :, None], b[:, :, :, None, :] - b[:, :, None, :, :], -jnp.inf)
        a = jnp.einsum('bhtd,bhtsd,bhsd->bhts', qc, jnp.exp(diff), kc)
        o_intra = jnp.einsum('bhts,bhse->bhte', a, vc)
        S = jnp.exp(b_last[:, :, 0, :, None]) * S + jnp.einsum('bhsd,bhse->bhde', kc * jnp.exp(b_last - b), vc)
        return S, o_inter + o_intra

    S0 = jnp.zeros((B, H, dk, dv), jnp.float32)
    _, o = lax.scan(step, S0, (to_chunks(q), to_chunks(k), to_chunks(v), to_chunks(log_f)))
    return jnp.moveaxis(o, 0, 2).reshape(B, H, T, dv)


def hgrn2_forget(z, lb_logits, layer):
    lb = jnp.cumsum(jax.nn.softmax(lb_logits.astype(jnp.float32), axis=0), axis=0)[layer]
    lb = lb.reshape(HG_HEADS, 1, HG_HEAD_DIM)
    f = lb + (1.0 - lb) * jax.nn.sigmoid(z)
    return jnp.log(f), 1.0 - f


def hybrid_layer(x, layer, w_in, b_in, rpb, lb_fwd_logits, lb_bwd_logits, hg_norm_gain,
                 w_out, b_out, ln_gain, ln_bias):
    B, T, _ = x.shape
    h = jnp.einsum('btd,de->bte', x, w_in) + b_in
    split_at = list(np.cumsum(IN_WIDTHS)[:-1])
    q_a, k_a, v_a, g_a, q_h, z_fwd, z_bwd, i_h, g_h = jnp.split(h, split_at, axis=-1)

    heads_a = lambda t: t.reshape(B, T, ATT_HEADS, ATT_HEAD_DIM)
    o_a = neighbourhood_attention(heads_a(q_a), heads_a(k_a), heads_a(v_a), rpb)
    o_a = o_a * jax.nn.silu(g_a)

    heads_h = lambda t: t.reshape(B, T, HG_HEADS, HG_HEAD_DIM).transpose(0, 2, 1, 3).astype(jnp.float32)
    qh, ih = heads_h(q_h), heads_h(i_h)
    logf_f, k_f = hgrn2_forget(heads_h(z_fwd), lb_fwd_logits, layer)
    logf_b, k_b = hgrn2_forget(heads_h(z_bwd), lb_bwd_logits, layer)
    o_fwd = hgrn2_chunk_scan(qh, k_f, ih, logf_f)
    flip = lambda t: jnp.flip(t, axis=2)
    o_bwd = flip(hgrn2_chunk_scan(flip(qh), flip(k_b), flip(ih), flip(logf_b)))
    o_h = (o_fwd + o_bwd).transpose(0, 2, 1, 3)
    o_h = o_h * lax.rsqrt(jnp.mean(jnp.square(o_h), axis=-1, keepdims=True) + RMS_EPS)
    o_h = o_h.reshape(B, T, D_HG) * hg_norm_gain.astype(jnp.float32)
    o_h = o_h.astype(x.dtype) * jax.nn.silu(g_h)

    y = jnp.einsum('bte,ed->btd', jnp.concatenate([o_a, o_h], axis=-1), w_out) + b_out
    r = (DEEPNORM_ALPHA * x + y).astype(jnp.float32)
    mu = jnp.mean(r, axis=-1, keepdims=True)
    var = jnp.mean(jnp.square(r - mu), axis=-1, keepdims=True)
    r = (r - mu) * lax.rsqrt(var + LN_EPS) * ln_gain.astype(jnp.float32) + ln_bias.astype(jnp.float32)
    return r.astype(x.dtype)


def setup_inputs(seed: int = 0) -> dict:
    key = jax.random.key(seed)
    ks = jax.random.split(key, 12)
    x = jax.random.normal(ks[0], (BATCH, SEQ, D_MODEL), jnp.float32)
    col_scale = np.ones((D_IN,), np.float32)
    off = np.cumsum((0,) + IN_WIDTHS)
    col_scale[off[2]:off[3]] = DEEPNORM_BETA
    col_scale[off[7]:off[8]] = DEEPNORM_BETA
    w_in = jax.random.normal(ks[1], (DEPTH, D_MODEL, D_IN), jnp.float32) * (D_MODEL ** -0.5) * jnp.asarray(col_scale)
    b_in = 0.02 * jax.random.normal(ks[2], (DEPTH, D_IN), jnp.float32)
    rpb = 0.1 * jax.random.normal(ks[3], (DEPTH, ATT_HEADS, 2 * WIN_ROWS_MAX - 1, 2 * WIN_COLS - 1), jnp.float32)
    lb_fwd_logits = 0.5 * jax.random.normal(ks[4], (DEPTH + 1, D_HG), jnp.float32)
    lb_bwd_logits = 0.5 * jax.random.normal(ks[5], (DEPTH + 1, D_HG), jnp.float32)
    hg_norm_gain = 1.0 + 0.02 * jax.random.normal(ks[6], (DEPTH, D_HG), jnp.float32)
    w_out = jax.random.normal(ks[7], (DEPTH, D_MIX, D_MODEL), jnp.float32) * (D_MIX ** -0.5) * DEEPNORM_BETA
    b_out = 0.02 * jax.random.normal(ks[8], (DEPTH, D_MODEL), jnp.float32)
    ln_gain = 1.0 + 0.02 * jax.random.normal(ks[9], (DEPTH, D_MODEL), jnp.float32)
    ln_bias = 0.02 * jax.random.normal(ks[10], (DEPTH, D_MODEL), jnp.float32)
    return {"x": x, "w_in": w_in, "b_in": b_in, "rpb": rpb,
            "lb_fwd_logits": lb_fwd_logits, "lb_bwd_logits": lb_bwd_logits,
            "hg_norm_gain": hg_norm_gain, "w_out": w_out, "b_out": b_out,
            "ln_gain": ln_gain, "ln_bias": ln_bias}


def reference(x, w_in, b_in, rpb, lb_fwd_logits, lb_bwd_logits, hg_norm_gain,
              w_out, b_out, ln_gain, ln_bias):
    for layer in range(DEPTH):
        x = hybrid_layer(x, layer, w_in[layer], b_in[layer], rpb[layer],
                         lb_fwd_logits, lb_bwd_logits, hg_norm_gain[layer],
                         w_out[layer], b_out[layer], ln_gain[layer], ln_bias[layer])
    return x
```

```cpp
#include <hip/hip_runtime.h>
#include <hip/hip_cooperative_groups.h>
#include <cstdio>
#include <cstdint>
namespace cg = cooperative_groups;
namespace pg8 {
#define PG8_LAS __attribute__((address_space(3)))
typedef unsigned short bf16_t;
typedef short bf16x8 __attribute__((ext_vector_type(8)));
typedef float f32x4 __attribute__((ext_vector_type(4)));
typedef unsigned u32x4 __attribute__((ext_vector_type(4)));
constexpr int BM = 256, BK = 64, HALF = 128, HTB = HALF * BK * 2  , STAGE_BYTES = 8 * HTB, NXCD = 8, WGM = 8;

__host__ __device__ __forceinline__ int lds_byte(int r, int c) { const int st = (r >> 4) * 2 + (c >> 5), rr = r & 15, cc = c & 31, ob = rr * 64 + cc * 2; return st * 1024 + (ob ^ (((ob >> 9) & 1) << 5)); }
__host__ __device__ __forceinline__ void stage_rc(int b, int& R, int& C) { const int st = b / 1024, sb = b % 1024, swz = sb ^ (((sb >> 9) & 1) << 5); R = (st >> 1) * 16 + swz / 64; C = (st & 1) * 32 + (swz % 64) / 2; }
__host__ __device__ __forceinline__ int perm32(int rho) { const int n = rho >> 4, i = rho & 15; return 8 * (i >> 2) + 4 * n + (i & 3); }

struct Unit { int pm, pn; };
struct Gemm { const bf16_t* A; const bf16_t* Bt; int M, N, K; };

struct StaticOrder {
    int nM, nN, nwg, G, c;
    __host__ __device__ void init(int M, int N, int G_, int c_) { nM = M / BM; nN = N / BM; nwg = nM * nN; G = G_; c = c_; }
    __host__ __device__ bool next(int i, Unit& u) const {
        const long L = (long)i * G + c; if (L >= nwg) return false;
        int wgid = (int)L; { const int q = nwg / NXCD, r = nwg % NXCD, xcd = wgid % NXCD, off = wgid / NXCD; wgid = (xcd < r ? xcd * (q + 1) : r * (q + 1) + (xcd - r) * q) + off; }
        const int nig = WGM * nN, gid = wgid / nig, fm = gid * WGM, gsz = (nM - fm) < WGM ? (nM - fm) : WGM;
        u.pm = fm + ((wgid % nig) % gsz); u.pn = (wgid % nig) / gsz; return true;
    }
    __device__ __forceinline__ void a_ready(const Unit&) const {}
    __device__ __forceinline__ void done(const Unit&) const {}
};
__device__ __forceinline__ unsigned cvt_pk_bf16(float lo, float hi) { unsigned r; asm volatile("v_cvt_pk_bf16_f32 %0, %1, %2" : "=v"(r) : "v"(lo), "v"(hi)); return r; }
template <class Epi, class Sched, bool ALIGN_EPI = false, bool SP2 = false>
__device__ __forceinline__ void gemm_phase(PG8_LAS unsigned char* lds, const Gemm g, const Sched& S, const Epi& E) {
    const int tid = threadIdx.x, wid = __builtin_amdgcn_readfirstlane(tid >> 6), lane = tid & 63, wr = wid >> 2, wc = wid & 3, fr = lane & 15, fq = lane >> 4;
    const int K = g.K, nt = K / BK;
    unsigned voffA[2], voffB[2];
#pragma unroll
    for (int i = 0; i < 2; ++i) { int R, C; stage_rc(tid * 16 + i * 8192, R, C); const int Rb = Epi::PERM ? ((R & ~31) + perm32(R & 31)) : R;
        voffA[i] = (unsigned)(R * K + C) * 2u; voffB[i] = (unsigned)(Rb * K + C) * 2u; }
    const size_t kstep = (size_t)(BK * 2);
    const size_t hstep = (size_t)HALF * K * 2;
    const size_t tstep = 2 * hstep;
    const unsigned ldsw = (unsigned)wid * 1024u;
    const int aoff = lds_byte(wr * 64 + fr, fq * 8), boff = lds_byte(wc * 32 + fr, fq * 8);
#define PG8_SA(b, h) (((b) * 2 + (h)) * HTB)
#define PG8_SB(b, h) ((4 + (b) * 2 + (h)) * HTB)
#define PG8_STAGE(bufoff, gbase, voff) do { _Pragma("unroll") for (int _i = 0; _i < 2; ++_i) \
        __builtin_amdgcn_global_load_lds((const unsigned*)((const char*)(gbase) + (voff)[_i]), (PG8_LAS unsigned*)(lds + (bufoff) + ldsw + _i * 8192), 16, 0, 0); } while (0)
#define PG8_LDA(dst, b, h) do { _Pragma("unroll") for (int m = 0; m < 4; ++m) _Pragma("unroll") for (int k = 0; k < 2; ++k) dst[m][k] = *(const PG8_LAS bf16x8*)(lds + PG8_SA(b, h) + aoff + m * 2048 + k * 1024); } while (0)
#define PG8_LDB(dst, b, h) do { _Pragma("unroll") for (int n = 0; n < 2; ++n) _Pragma("unroll") for (int k = 0; k < 2; ++k) dst[n][k] = *(const PG8_LAS bf16x8*)(lds + PG8_SB(b, h) + boff + n * 2048 + k * 1024); } while (0)
#define PG8_MMA(ai, bj, At, Bt) do { __builtin_amdgcn_s_setprio(1); _Pragma("unroll") for (int m = 0; m < 4; ++m) _Pragma("unroll") for (int n = 0; n < 2; ++n) _Pragma("unroll") for (int k = 0; k < 2; ++k) \
        acc[ai][bj][m][n] = __builtin_amdgcn_mfma_f32_16x16x32_bf16(Bt[n][k], At[m][k], acc[ai][bj][m][n], 0, 0, 0); __builtin_amdgcn_s_setprio(0); } while (0)
#define PG8_WAIT_V(n) asm volatile("s_waitcnt vmcnt(" #n ")" ::: "memory")
#define PG8_WAIT_L(n) asm volatile("s_waitcnt lgkmcnt(" #n ")" ::: "memory")
#define PG8_BAR __builtin_amdgcn_s_barrier()
#define PG8_SCHED __builtin_amdgcn_sched_barrier(0)
    Unit cur, nxt; int ui = 0;
    if (!S.next(0, cur)) return;
    f32x4 acc[2][2][4][2];
#pragma unroll
    for (int a = 0; a < 2; ++a)
#pragma unroll
        for (int b = 0; b < 2; ++b)
#pragma unroll
            for (int m = 0; m < 4; ++m)
#pragma unroll
                for (int n = 0; n < 2; ++n) acc[a][b][m][n] = (f32x4){0.f, 0.f, 0.f, 0.f};
    bf16x8 At[4][2], B0[2][2], B1[2][2];
    const char* cA = (const char*)g.A + (size_t)cur.pm * tstep; const char* cB = (const char*)g.Bt + (size_t)cur.pn * tstep;
    S.a_ready(cur);
    if constexpr (SP2) {
        PG8_STAGE(PG8_SB(0, 0), cB, voffB); PG8_STAGE(PG8_SB(0, 1), cB + hstep, voffB); PG8_STAGE(PG8_SA(0, 0), cA, voffA); PG8_STAGE(PG8_SA(0, 1), cA + hstep, voffA);
        if (wr == 1) PG8_BAR;
        PG8_WAIT_V(2); PG8_BAR;
        PG8_STAGE(PG8_SB(1, 0), cB + kstep, voffB); PG8_STAGE(PG8_SA(1, 0), cA + kstep, voffA); PG8_STAGE(PG8_SB(1, 1), cB + hstep + kstep, voffB);
        PG8_WAIT_V(6); PG8_BAR;
    } else {
        PG8_STAGE(PG8_SB(0, 0), cB, voffB); PG8_STAGE(PG8_SA(0, 0), cA, voffA); PG8_STAGE(PG8_SB(0, 1), cB + hstep, voffB); PG8_STAGE(PG8_SA(0, 1), cA + hstep, voffA);
        if (wr == 1) PG8_BAR;
        PG8_WAIT_V(4); PG8_BAR;
        PG8_STAGE(PG8_SB(1, 0), cB + kstep, voffB); PG8_STAGE(PG8_SA(1, 0), cA + kstep, voffA); PG8_STAGE(PG8_SB(1, 1), cB + hstep + kstep, voffB);
        PG8_WAIT_V(6); PG8_BAR;
    }
    for (;;) {
        const bool has_next = S.next(ui + 1, nxt);
        const char* nA = has_next ? (const char*)g.A + (size_t)nxt.pm * tstep : cA; const char* nB = has_next ? (const char*)g.Bt + (size_t)nxt.pn * tstep : cB;
        for (int t = 0; t < nt; t += 2) {
            const bool last = (t == nt - 2);
            const char* a1 = cA + (size_t)(t + 1) * kstep;
            const char* a2 = last ? nA : cA + (size_t)(t + 2) * kstep; const char* b2 = last ? nB : cB + (size_t)(t + 2) * kstep;
            const char* a3 = a2 + kstep; const char* b3 = b2 + kstep;
            if (last && has_next) S.a_ready(nxt);
            if constexpr (SP2) {
            PG8_LDB(B0, 0, 0); PG8_LDB(B1, 0, 1); PG8_SCHED; PG8_LDA(At, 0, 0); PG8_STAGE(PG8_SA(1, 1), a1 + hstep, voffA);
            PG8_WAIT_V(8); PG8_WAIT_L(0); PG8_BAR; PG8_MMA(0, 0, At, B0); PG8_MMA(0, 1, At, B1); PG8_BAR; PG8_SCHED;
            PG8_LDA(At, 0, 1); PG8_STAGE(PG8_SB(0, 0), b2, voffB); PG8_STAGE(PG8_SB(0, 1), b2 + hstep, voffB); PG8_STAGE(PG8_SA(0, 0), a2, voffA);
            PG8_WAIT_V(8); PG8_WAIT_L(0); PG8_BAR; PG8_MMA(1, 0, At, B0); PG8_MMA(1, 1, At, B1); PG8_BAR; PG8_SCHED;
            PG8_LDB(B0, 1, 0); PG8_LDB(B1, 1, 1); PG8_SCHED; PG8_LDA(At, 1, 0); PG8_STAGE(PG8_SA(0, 1), a2 + hstep, voffA);
            PG8_WAIT_V(8); PG8_WAIT_L(0); PG8_BAR; PG8_MMA(0, 0, At, B0); PG8_MMA(0, 1, At, B1); PG8_BAR; PG8_SCHED;
            PG8_LDA(At, 1, 1); PG8_STAGE(PG8_SB(1, 0), b3, voffB); PG8_STAGE(PG8_SB(1, 1), b3 + hstep, voffB); PG8_STAGE(PG8_SA(1, 0), a3, voffA);
            PG8_WAIT_V(8); PG8_WAIT_L(0); PG8_BAR; PG8_MMA(1, 0, At, B0); PG8_MMA(1, 1, At, B1); PG8_BAR; PG8_SCHED;
            } else {
            PG8_LDB(B0, 0, 0); PG8_SCHED; PG8_LDA(At, 0, 0); PG8_STAGE(PG8_SA(1, 1), a1 + hstep, voffA);
            PG8_WAIT_L(8); PG8_BAR; PG8_WAIT_L(0); PG8_MMA(0, 0, At, B0); PG8_BAR; PG8_SCHED;
            PG8_LDB(B1, 0, 1); PG8_STAGE(PG8_SB(0, 0), b2, voffB);
            PG8_BAR; PG8_WAIT_L(0); PG8_MMA(0, 1, At, B1); PG8_BAR;
            PG8_LDA(At, 0, 1); PG8_STAGE(PG8_SA(0, 0), a2, voffA);
            PG8_BAR; PG8_WAIT_L(0); PG8_MMA(1, 0, At, B0); PG8_BAR; PG8_SCHED;
            PG8_STAGE(PG8_SB(0, 1), b2 + hstep, voffB);
            PG8_WAIT_V(6); PG8_BAR; PG8_MMA(1, 1, At, B1); PG8_BAR;
            PG8_LDB(B0, 1, 0); PG8_SCHED; PG8_LDA(At, 1, 0); PG8_STAGE(PG8_SA(0, 1), a2 + hstep, voffA);
            PG8_WAIT_L(8); PG8_BAR; PG8_WAIT_L(0); PG8_MMA(0, 0, At, B0); PG8_BAR; PG8_SCHED;
            PG8_LDB(B1, 1, 1); PG8_STAGE(PG8_SB(1, 0), b3, voffB);
            PG8_BAR; PG8_WAIT_L(0); PG8_MMA(0, 1, At, B1); PG8_BAR;
            PG8_LDA(At, 1, 1); PG8_STAGE(PG8_SA(1, 0), a3, voffA);
            PG8_BAR; PG8_WAIT_L(0); PG8_MMA(1, 0, At, B0); PG8_BAR; PG8_SCHED;
            PG8_STAGE(PG8_SB(1, 1), b3 + hstep, voffB);
            PG8_WAIT_V(6); PG8_BAR; PG8_MMA(1, 1, At, B1); PG8_BAR;
            }
        }
        if constexpr (ALIGN_EPI) { if (wr == 0) PG8_BAR; }
        if constexpr (!Epi::AFTER_DRAIN) { E(acc, cur, wr, wc, fr, fq); S.done(cur); }
        if (!has_next) break;
#pragma unroll
        for (int a = 0; a < 2; ++a)
#pragma unroll
            for (int b = 0; b < 2; ++b)
#pragma unroll
                for (int m = 0; m < 4; ++m)
#pragma unroll
                    for (int n = 0; n < 2; ++n) acc[a][b][m][n] = (f32x4){0.f, 0.f, 0.f, 0.f};
        cur = nxt; cA = nA; cB = nB; ++ui;
        if constexpr (ALIGN_EPI) { if (wr == 1) PG8_BAR; }
    }
    PG8_WAIT_V(0);
    if constexpr (!ALIGN_EPI) { if (wr == 0) PG8_BAR; }
    PG8_BAR;
    if constexpr (Epi::AFTER_DRAIN) { E.fused(acc, cur, wr, wc, fr, fq, lds, wid, lane); S.done(cur); }
#undef PG8_SA
#undef PG8_SB
#undef PG8_STAGE
#undef PG8_LDA
#undef PG8_LDB
#undef PG8_MMA
#undef PG8_WAIT_V
#undef PG8_WAIT_L
#undef PG8_BAR
#undef PG8_SCHED
}
}

#ifndef MK_LAUNCHES
#define MK_LAUNCHES 1
#endif
#define LAS __attribute__((address_space(3)))
typedef unsigned short bf16_t;
typedef short bf16x8 __attribute__((ext_vector_type(8)));
typedef float f32x4 __attribute__((ext_vector_type(4)));
typedef unsigned u32x4 __attribute__((ext_vector_type(4)));
typedef unsigned u32x2 __attribute__((ext_vector_type(2)));

constexpr int NTHREADS = 512;
constexpr int BATCH = 2, SEQ = 8192, DM = 1024, MROWS = BATCH * SEQ, DIN = 4608;
constexpr int C_QA = 0, C_KA = 512, C_VA = 1024, C_GA = 1536, C_QH = 2048, C_ZF = 2560, C_ZB = 3072, C_IH = 3584, C_GH = 4096;
constexpr float ALPHA = 1.189207115002721f;
constexpr size_t MiB = 1u << 20;
constexpr size_t WS_US = 0;
constexpr size_t WS_WIN = 64 * MiB, WS_WOUT = 73 * MiB, WS_DEC = 75 * MiB;
constexpr size_t WS_H = 80 * MiB;
constexpr size_t WS_CAT = 224 * MiB;
constexpr int LDS_BYTES = 158720;

struct Args { const float* in[11]; float* out; unsigned char* ws; int ph_lo, ph_hi, coop, pad; };

__device__ __forceinline__ float bf2f(unsigned v) { return __builtin_bit_cast(float, v << 16); }
__device__ __forceinline__ unsigned f2bf(float f) { unsigned u = __builtin_bit_cast(unsigned, f); return (u + 0x7fffu + ((u >> 16) & 1u)) >> 16; }
__device__ __forceinline__ unsigned pk2(float lo, float hi) { return pg8::cvt_pk_bf16(lo, hi); }
__device__ __forceinline__ float sigmoidf_(float z) { return 1.f / (1.f + __expf(-z)); }
__device__ __forceinline__ float siluf_(float z) { return z / (1.f + __expf(-z)); }
__device__ __forceinline__ bf16x8 as_bf16x8(u32x4 v) { return __builtin_bit_cast(bf16x8, v); }

struct EpiH {
    static constexpr bool PERM = true, AFTER_DRAIN = false;
    bf16_t* O; const float* bias;
    __device__ __forceinline__ void operator()(const f32x4 (&acc)[2][2][4][2], const pg8::Unit& u, int wr, int wc, int fr, int fq) const {
        const int row0 = u.pm * 256 + wr * 64 + fr, col0 = u.pn * 256 + wc * 32 + 8 * fq;
        f32x4 bv[2][2];
#pragma unroll
        for (int bj = 0; bj < 2; ++bj)
#pragma unroll
            for (int n = 0; n < 2; ++n) bv[bj][n] = *(const f32x4*)(bias + col0 + bj * 128 + 4 * n);
#pragma unroll
        for (int ai = 0; ai < 2; ++ai)
#pragma unroll
            for (int m = 0; m < 4; ++m) { bf16_t* rowp = O + (size_t)(row0 + ai * 128 + m * 16) * DIN + col0;
#pragma unroll
                for (int bj = 0; bj < 2; ++bj) { f32x4 v0 = acc[ai][bj][m][0] + bv[bj][0], v1 = acc[ai][bj][m][1] + bv[bj][1];
                    u32x4 w; w.x = pk2(v0[0], v0[1]); w.y = pk2(v0[2], v0[3]); w.z = pk2(v1[0], v1[1]); w.w = pk2(v1[2], v1[3]);
                    *(u32x4*)(rowp + bj * 128) = w; } }
    }
};
struct EpiR {
    static constexpr bool PERM = false, AFTER_DRAIN = false;
    float* R; const float* bias; const float* x;
    __device__ __forceinline__ void operator()(const f32x4 (&acc)[2][2][4][2], const pg8::Unit& u, int wr, int wc, int fr, int fq) const {
        const int row0 = u.pm * 256 + wr * 64 + fr, col0 = u.pn * 256 + wc * 32 + 4 * fq;
        f32x4 bv[2][2];
#pragma unroll
        for (int bj = 0; bj < 2; ++bj)
#pragma unroll
            for (int n = 0; n < 2; ++n) bv[bj][n] = *(const f32x4*)(bias + col0 + bj * 128 + n * 16);
#pragma unroll
        for (int ai = 0; ai < 2; ++ai)
#pragma unroll
            for (int m = 0; m < 4; ++m) { const size_t ro = (size_t)(row0 + ai * 128 + m * 16) * DM + col0;
#pragma unroll
                for (int bj = 0; bj < 2; ++bj)
#pragma unroll
                    for (int n = 0; n < 2; ++n) { const f32x4 xv = *(const f32x4*)(x + ro + bj * 128 + n * 16);
                        *(f32x4*)(R + ro + bj * 128 + n * 16) = acc[ai][bj][m][n] + bv[bj][n] + xv * ALPHA; } }
    }
};

__device__ __forceinline__ void p0_convert(const float* x, const float* w_in, const float* w_out, bf16_t* XB, bf16_t* WIN, bf16_t* WOUT) {
    const int gt = blockIdx.x * NTHREADS + threadIdx.x, GT = gridDim.x * NTHREADS;
    for (int i = gt; i < MROWS * DM / 8; i += GT) {
        const f32x4 a = *(const f32x4*)(x + (size_t)i * 8), b = *(const f32x4*)(x + (size_t)i * 8 + 4);
        u32x4 w; w.x = pk2(a[0], a[1]); w.y = pk2(a[2], a[3]); w.z = pk2(b[0], b[1]); w.w = pk2(b[2], b[3]);
        *(u32x4*)(XB + (size_t)i * 8) = w;
    }
    for (int i = gt; i < DIN * 128; i += GT) {
        const int n = i % DIN, kb = i / DIN; float v[8];
#pragma unroll
        for (int j = 0; j < 8; ++j) v[j] = w_in[(size_t)(kb * 8 + j) * DIN + n];
        u32x4 w; w.x = pk2(v[0], v[1]); w.y = pk2(v[2], v[3]); w.z = pk2(v[4], v[5]); w.w = pk2(v[6], v[7]);
        *(u32x4*)(WIN + (size_t)n * 1024 + kb * 8) = w;
    }
    for (int i = gt; i < DM * 128; i += GT) {
        const int n = i % DM, kb = i / DM; float v[8];
#pragma unroll
        for (int j = 0; j < 8; ++j) v[j] = w_out[(size_t)(kb * 8 + j) * DM + n];
        u32x4 w; w.x = pk2(v[0], v[1]); w.y = pk2(v[2], v[3]); w.z = pk2(v[4], v[5]); w.w = pk2(v[6], v[7]);
        *(u32x4*)(WOUT + (size_t)n * 1024 + kb * 8) = w;
    }
}

constexpr int AT_VP = 520;
constexpr int AT_RPB_OFF = 2 * 64 * AT_VP * 2;
__device__ __forceinline__ void attn_tile(LAS unsigned char* lds, const bf16_t* H, const float* rpb, bf16_t* CAT, int at) {
    const int tid = threadIdx.x, lane = tid & 63, w = tid >> 6, fr = lane & 15, g = lane >> 4;
    const int b = at >> 9, hp = (at >> 7) & 3, r = at & 127;
    int rs = r - 4; rs = rs < 0 ? 0 : (rs > 120 ? 120 : rs);
    LAS bf16_t* VT = (LAS bf16_t*)lds;
    LAS float* RPB = (LAS float*)(lds + AT_RPB_OFF);
    {
        const size_t tok = (size_t)b * SEQ + (size_t)(rs + (tid >> 6)) * 64 + (tid & 63);
#pragma unroll
        for (int hh = 0; hh < 2; ++hh) {
            const bf16_t* src = H + tok * DIN + C_VA + (2 * hp + hh) * 64;
#pragma unroll
            for (int p = 0; p < 8; ++p) {
                const u32x4 v = *(const u32x4*)(src + 8 * p);
#pragma unroll
                for (int i = 0; i < 4; ++i) {
                    VT[(hh * 64 + 8 * p + 2 * i) * AT_VP + tid] = (bf16_t)(v[i] & 0xffffu);
                    VT[(hh * 64 + 8 * p + 2 * i + 1) * AT_VP + tid] = (bf16_t)(v[i] >> 16);
                }
            }
        }
        for (int i = tid; i < 930; i += NTHREADS) RPB[i] = rpb[hp * 930 + i];
    }
    __syncthreads();
    const int hh = w >> 2, j = w & 3, head = 2 * hp + hh;
    const int kc0 = (j == 0) ? 0 : (j == 1 ? 8 : (j == 2 ? 24 : 32));
    const size_t qtok = (size_t)b * SEQ + (size_t)r * 64 + 16 * j + fr;
    bf16x8 qf[2];
#pragma unroll
    for (int ks = 0; ks < 2; ++ks) qf[ks] = as_bf16x8(*(const u32x4*)(H + qtok * DIN + C_QA + head * 64 + ks * 32 + 8 * g));
    f32x4 S[16];
#pragma unroll
    for (int kt = 0; kt < 16; ++kt) {
        const int a = kt >> 1, ch = kt & 1;
        const size_t ktok = (size_t)b * SEQ + (size_t)(rs + a) * 64 + kc0 + 16 * ch + fr;
        const bf16_t* kp = H + ktok * DIN + C_KA + head * 64 + 8 * g;
        const bf16x8 k0 = as_bf16x8(*(const u32x4*)(kp)), k1 = as_bf16x8(*(const u32x4*)(kp + 32));
        f32x4 acc = {0.f, 0.f, 0.f, 0.f};
        acc = __builtin_amdgcn_mfma_f32_16x16x32_bf16(k0, qf[0], acc, 0, 0, 0);
        acc = __builtin_amdgcn_mfma_f32_16x16x32_bf16(k1, qf[1], acc, 0, 0, 0);
        S[kt] = acc;
    }
    const int qcol = 16 * j + fr;
    int cs = qcol - 8; cs = cs < 0 ? 0 : (cs > 48 ? 48 : cs);
    float mx = -1e30f;
#pragma unroll
    for (int kt = 0; kt < 16; ++kt) {
        const int a = kt >> 1, ch = kt & 1;
        const int dr = rs + a - r + 7;
#pragma unroll
        for (int rg = 0; rg < 4; ++rg) {
            const int kcol = kc0 + 16 * ch + 4 * g + rg;
            int dc = kcol - qcol + 15; dc = dc < 0 ? 0 : (dc > 30 ? 30 : dc);
            const bool inw = (unsigned)(kcol - cs) < 16u;
            const float s = S[kt][rg] * 0.125f + RPB[hh * 465 + dr * 31 + dc];
            S[kt][rg] = inw ? s : -1e30f;
            mx = fmaxf(mx, S[kt][rg]);
        }
    }
    mx = fmaxf(mx, __shfl_xor(mx, 16)); mx = fmaxf(mx, __shfl_xor(mx, 32));
    float sum = 0.f;
#pragma unroll
    for (int kt = 0; kt < 16; ++kt)
#pragma unroll
        for (int rg = 0; rg < 4; ++rg) { const float p = __expf(S[kt][rg] - mx); S[kt][rg] = p; sum += p; }
    sum += __shfl_xor(sum, 16); sum += __shfl_xor(sum, 32);
    f32x4 O[4];
#pragma unroll
    for (int mt = 0; mt < 4; ++mt) O[mt] = (f32x4){0.f, 0.f, 0.f, 0.f};
#pragma unroll
    for (int kk = 0; kk < 8; ++kk) {
        u32x4 pw; pw.x = pk2(S[2 * kk][0], S[2 * kk][1]); pw.y = pk2(S[2 * kk][2], S[2 * kk][3]);
        pw.z = pk2(S[2 * kk + 1][0], S[2 * kk + 1][1]); pw.w = pk2(S[2 * kk + 1][2], S[2 * kk + 1][3]);
        const bf16x8 pf = as_bf16x8(pw);
        const int key1 = kk * 64 + kc0 + 4 * g;
#pragma unroll
        for (int mt = 0; mt < 4; ++mt) {
            const LAS bf16_t* vp = VT + (hh * 64 + 16 * mt + fr) * AT_VP + key1;
            const u32x2 lo = *(const LAS u32x2*)(vp), hi = *(const LAS u32x2*)(vp + 16);
            u32x4 vw; vw.x = lo.x; vw.y = lo.y; vw.z = hi.x; vw.w = hi.y;
            O[mt] = __builtin_amdgcn_mfma_f32_16x16x32_bf16(as_bf16x8(vw), pf, O[mt], 0, 0, 0);
        }
    }
    const float inv = 1.f / sum;
#pragma unroll
    for (int mt = 0; mt < 4; ++mt) {
        const int e = 16 * mt + 4 * g;
        const u32x2 gw = *(const u32x2*)(H + qtok * DIN + C_GA + head * 64 + e);
        const float g0 = bf2f(gw.x & 0xffffu), g1 = bf2f(gw.x >> 16), g2 = bf2f(gw.y & 0xffffu), g3 = bf2f(gw.y >> 16);
        u32x2 ow; ow.x = pk2(O[mt][0] * inv * siluf_(g0), O[mt][1] * inv * siluf_(g1)); ow.y = pk2(O[mt][2] * inv * siluf_(g2), O[mt][3] * inv * siluf_(g3));
        *(u32x2*)(CAT + qtok * DM + head * 64 + e) = ow;
    }
    __syncthreads();
}

constexpr int HG_QS = 0, HG_VT = 16384, HG_LF = 34816, HG_ZS = 67584, HG_QT = 83968, HG_KP = 101376, HG_KPT = 118784, HG_TOT = 137216, HG_DECS = 139264;
constexpr int HG_VP = 72, HG_QP = 136;
__device__ __forceinline__ void hgrn_local_tile(LAS unsigned char* lds, bf16_t* H, const float* lbf, const float* lbb, bf16_t* US, float* DEC, int ht) {
    const int tid = threadIdx.x, lane = tid & 63, w = tid >> 6, fr = lane & 15, g = lane >> 4;
    const int b = ht >> 9, h = (ht >> 7) & 3, c = ht & 127;
    const size_t tok0 = (size_t)b * SEQ + (size_t)c * 64;
    LAS bf16_t* QS = (LAS bf16_t*)(lds + HG_QS); LAS bf16_t* VT = (LAS bf16_t*)(lds + HG_VT); LAS float* LF = (LAS float*)(lds + HG_LF);
    LAS bf16_t* ZS = (LAS bf16_t*)(lds + HG_ZS); LAS bf16_t* QT = (LAS bf16_t*)(lds + HG_QT); LAS bf16_t* KP = (LAS bf16_t*)(lds + HG_KP);
    LAS bf16_t* KPT = (LAS bf16_t*)(lds + HG_KPT); LAS float* TOT = (LAS float*)(lds + HG_TOT); LAS float* DECS = (LAS float*)(lds + HG_DECS);
#pragma unroll
    for (int i = 0; i < 2; ++i) {
        const int p = tid + i * NTHREADS, s = p >> 4, d8 = (p & 15) * 8;
        const bf16_t* rowp = H + (tok0 + s) * DIN + h * 128 + d8;
        *(LAS u32x4*)(QS + s * 128 + d8) = *(const u32x4*)(rowp + C_QH);
        const u32x4 v = *(const u32x4*)(rowp + C_IH);
#pragma unroll
        for (int k = 0; k < 4; ++k) { VT[(d8 + 2 * k) * HG_VP + s] = (bf16_t)(v[k] & 0xffffu); VT[(d8 + 2 * k + 1) * HG_VP + s] = (bf16_t)(v[k] >> 16); }
    }
    const int d = tid & 127, sq = tid >> 7;
    const int tt = w & 3, eh = w >> 2;
    f32x4 OI[4];
#pragma unroll
    for (int nt = 0; nt < 4; ++nt) OI[nt] = (f32x4){0.f, 0.f, 0.f, 0.f};
    for (int dir = 0; dir < 2; ++dir) {
        const float* lbl = dir ? lbb : lbf;
        const float lb = 1.f / (1.f + __expf(lbl[512 + h * 128 + d] - lbl[h * 128 + d]));
        const int zc = dir ? C_ZB : C_ZF;
#pragma unroll
        for (int i = 0; i < 2; ++i) {
            const int p = tid + i * NTHREADS, s = p >> 4, d8 = (p & 15) * 8;
            *(LAS u32x4*)(ZS + s * 128 + d8) = *(const u32x4*)(H + (tok0 + s) * DIN + zc + h * 128 + d8);
        }
        __syncthreads();
        float kreg[16];
#pragma unroll
        for (int i = 0; i < 16; ++i) {
            const int s = sq + 4 * i;
            const float z = bf2f(ZS[s * 128 + d]);
            const float ez = __expf(-z), sg = 1.f / (1.f + ez);
            const float f = lb + (1.f - lb) * sg;
            LF[s * 128 + d] = __logf(f);
            kreg[i] = (1.f - lb) * (1.f - sg);
        }
        __syncthreads();
        {
            float run = 0.f;
#pragma unroll
            for (int i = 0; i < 16; ++i) {
                const int s = dir ? (16 * sq + 15 - i) : (16 * sq + i);
                run += LF[s * 128 + d]; LF[s * 128 + d] = run;
            }
            TOT[sq * 128 + d] = run;
        }
        __syncthreads();
        {
            const float t0 = TOT[d], t1 = TOT[128 + d], t2 = TOT[256 + d], t3 = TOT[384 + d];
            float pre[4];
            if (dir == 0) { pre[0] = 0.f; pre[1] = t0; pre[2] = t0 + t1; pre[3] = t0 + t1 + t2; }
            else          { pre[3] = 0.f; pre[2] = t3; pre[1] = t3 + t2; pre[0] = t3 + t2 + t1; }
            if (tid < 128) { const float dec = __expf(t0 + t1 + t2 + t3); DECS[d] = dec; DEC[((size_t)((dir * 8 + b * 4 + h) * 128 + c)) * 128 + d] = dec; }
#pragma unroll
            for (int i = 0; i < 16; ++i) {
                const int s = sq + 4 * i;
                const float bb = LF[s * 128 + d] + pre[i >> 2];
                const float eq = __expf(bb), ek = __expf(-bb);
                const float qv = bf2f(QS[s * 128 + d]);
                const bf16_t qt = (bf16_t)f2bf(qv * eq), kp = (bf16_t)f2bf(kreg[i] * ek);
                QT[s * HG_QP + d] = qt; KP[s * HG_QP + d] = kp; KPT[d * HG_VP + s] = kp;
            }
        }
        __syncthreads();
        {
            f32x4 aT[4];
#pragma unroll
            for (int st = 0; st < 4; ++st) {
                f32x4 acc = {0.f, 0.f, 0.f, 0.f};
                const bool live = dir ? (st >= tt) : (st <= tt);
                if (live) {
#pragma unroll
                    for (int ks = 0; ks < 4; ++ks) {
                        const bf16x8 af = *(const LAS bf16x8*)(KP + (16 * st + fr) * HG_QP + 32 * ks + 8 * g);
                        const bf16x8 bfr = *(const LAS bf16x8*)(QT + (16 * tt + fr) * HG_QP + 32 * ks + 8 * g);
                        acc = __builtin_amdgcn_mfma_f32_16x16x32_bf16(af, bfr, acc, 0, 0, 0);
                    }
                    const int t = 16 * tt + fr;
#pragma unroll
                    for (int rg = 0; rg < 4; ++rg) { const int s = 16 * st + 4 * g + rg; const bool keep = dir ? (s >= t) : (s <= t); acc[rg] = keep ? acc[rg] : 0.f; }
                }
                aT[st] = acc;
            }
#pragma unroll
            for (int kk = 0; kk < 2; ++kk) {
                u32x4 aw; aw.x = pk2(aT[2 * kk][0], aT[2 * kk][1]); aw.y = pk2(aT[2 * kk][2], aT[2 * kk][3]);
                aw.z = pk2(aT[2 * kk + 1][0], aT[2 * kk + 1][1]); aw.w = pk2(aT[2 * kk + 1][2], aT[2 * kk + 1][3]);
                const bf16x8 af = as_bf16x8(aw);
#pragma unroll
                for (int nt = 0; nt < 4; ++nt) {
                    const LAS bf16_t* vp = VT + (64 * eh + 16 * nt + fr) * HG_VP + 32 * kk + 4 * g;
                    const u32x2 lo = *(const LAS u32x2*)(vp), hi = *(const LAS u32x2*)(vp + 16);
                    u32x4 vw; vw.x = lo.x; vw.y = lo.y; vw.z = hi.x; vw.w = hi.y;
                    OI[nt] = __builtin_amdgcn_mfma_f32_16x16x32_bf16(af, as_bf16x8(vw), OI[nt], 0, 0, 0);
                }
            }
        }
        {
            const bf16x8 va0 = *(const LAS bf16x8*)(VT + (16 * w + fr) * HG_VP + 8 * g), va1 = *(const LAS bf16x8*)(VT + (16 * w + fr) * HG_VP + 32 + 8 * g);
            bf16_t* up = US + ((size_t)((dir * 8 + b * 4 + h) * 128 + c)) * 16384;
#pragma unroll
            for (int dt = 0; dt < 8; ++dt) {
                const bf16x8 kb0 = *(const LAS bf16x8*)(KPT + (16 * dt + fr) * HG_VP + 8 * g), kb1 = *(const LAS bf16x8*)(KPT + (16 * dt + fr) * HG_VP + 32 + 8 * g);
                f32x4 acc = {0.f, 0.f, 0.f, 0.f};
                acc = __builtin_amdgcn_mfma_f32_16x16x32_bf16(va0, kb0, acc, 0, 0, 0);
                acc = __builtin_amdgcn_mfma_f32_16x16x32_bf16(va1, kb1, acc, 0, 0, 0);
                const float dec = DECS[16 * dt + fr];
#pragma unroll
                for (int rg = 0; rg < 4; ++rg) up[(16 * w + 4 * g + rg) * 128 + 16 * dt + fr] = (bf16_t)f2bf(acc[rg] * dec);
            }
        }
#pragma unroll
        for (int i = 0; i < 2; ++i) {
            const int p = tid + i * NTHREADS, s = p >> 4, d8 = (p & 15) * 8;
            *(u32x4*)(H + (tok0 + s) * DIN + zc + h * 128 + d8) = *(const LAS u32x4*)(QT + s * HG_QP + d8);
        }
        __syncthreads();
    }
#pragma unroll
    for (int nt = 0; nt < 4; ++nt)
#pragma unroll
        for (int rg = 0; rg < 4; ++rg)
            H[(tok0 + 16 * tt + 4 * g + rg) * DIN + C_QH + h * 128 + 64 * eh + 16 * nt + fr] = (bf16_t)f2bf(OI[nt][rg]);
}

__device__ __forceinline__ void hgrn_state_scan(bf16_t* US, const float* DEC) {
    const int gt = blockIdx.x * NTHREADS + threadIdx.x, GT = gridDim.x * NTHREADS;
    for (int it = gt; it < 16 * 8192; it += GT) {
        const int sidx = it >> 13, rem = (it & 8191) * 2, d = rem & 127, dir = sidx >> 3;
        float s0 = 0.f, s1 = 0.f;
        for (int c0 = 0; c0 < 128; c0 += 8) {
            unsigned u[8]; float2 dc[8];
#pragma unroll
            for (int k = 0; k < 8; ++k) {
                const int c = dir ? (127 - c0 - k) : (c0 + k);
                u[k] = *(const unsigned*)(US + ((size_t)(sidx * 128 + c)) * 16384 + rem);
                dc[k] = *(const float2*)(DEC + ((size_t)(sidx * 128 + c)) * 128 + d);
            }
#pragma unroll
            for (int k = 0; k < 8; ++k) {
                const int c = dir ? (127 - c0 - k) : (c0 + k);
                *(unsigned*)(US + ((size_t)(sidx * 128 + c)) * 16384 + rem) = pk2(s0, s1);
                s0 = dc[k].x * s0 + bf2f(u[k] & 0xffffu); s1 = dc[k].y * s1 + bf2f(u[k] >> 16);
            }
        }
    }
}

__device__ __forceinline__ void hgrn_out_tile(LAS unsigned char* lds, const bf16_t* H, const bf16_t* US, const float* gain, bf16_t* CAT, int ht) {
    const int tid = threadIdx.x, lane = tid & 63, w = tid >> 6, fr = lane & 15, g = lane >> 4;
    const int b = ht >> 9, h = (ht >> 7) & 3, c = ht & 127;
    const size_t tok0 = (size_t)b * SEQ + (size_t)c * 64;
    const int tt = w & 3, eh = w >> 2;
    LAS float* SSQ = (LAS float*)lds;
    f32x4 acc[4];
#pragma unroll
    for (int nt = 0; nt < 4; ++nt) acc[nt] = (f32x4){0.f, 0.f, 0.f, 0.f};
#pragma unroll
    for (int dir = 0; dir < 2; ++dir) {
        const bf16_t* qp = H + (tok0 + 16 * tt + fr) * DIN + (dir ? C_ZB : C_ZF) + h * 128 + 8 * g;
        const bf16_t* sp = US + ((size_t)((dir * 8 + b * 4 + h) * 128 + c)) * 16384 + 8 * g;
        bf16x8 qa[4];
#pragma unroll
        for (int ks = 0; ks < 4; ++ks) qa[ks] = as_bf16x8(*(const u32x4*)(qp + 32 * ks));
#pragma unroll
        for (int nt = 0; nt < 4; ++nt)
#pragma unroll
            for (int ks = 0; ks < 4; ++ks) {
                const bf16x8 sb = as_bf16x8(*(const u32x4*)(sp + (64 * eh + 16 * nt + fr) * 128 + 32 * ks));
                acc[nt] = __builtin_amdgcn_mfma_f32_16x16x32_bf16(qa[ks], sb, acc[nt], 0, 0, 0);
            }
    }
    float ssq[4] = {0.f, 0.f, 0.f, 0.f};
#pragma unroll
    for (int nt = 0; nt < 4; ++nt)
#pragma unroll
        for (int rg = 0; rg < 4; ++rg) {
            acc[nt][rg] += bf2f(H[(tok0 + 16 * tt + 4 * g + rg) * DIN + C_QH + h * 128 + 64 * eh + 16 * nt + fr]);
            ssq[rg] += acc[nt][rg] * acc[nt][rg];
        }
#pragma unroll
    for (int rg = 0; rg < 4; ++rg) {
        float v = ssq[rg];
        v += __shfl_xor(v, 1); v += __shfl_xor(v, 2); v += __shfl_xor(v, 4); v += __shfl_xor(v, 8);
        ssq[rg] = v;
    }
    if (fr == 0) {
#pragma unroll
        for (int rg = 0; rg < 4; ++rg) SSQ[eh * 64 + 16 * tt + 4 * g + rg] = ssq[rg];
    }
    __syncthreads();
#pragma unroll
    for (int rg = 0; rg < 4; ++rg) {
        const int t = 16 * tt + 4 * g + rg;
        const float rsn = rsqrtf((SSQ[t] + SSQ[64 + t]) * (1.f / 128.f) + 1e-6f);
#pragma unroll
        for (int nt = 0; nt < 4; ++nt) {
            const int e = h * 128 + 64 * eh + 16 * nt + fr;
            const float gh = bf2f(H[(tok0 + t) * DIN + C_GH + e]);
            CAT[(tok0 + t) * DM + 512 + e] = (bf16_t)f2bf(acc[nt][rg] * rsn * gain[e] * siluf_(gh));
        }
    }
    __syncthreads();
}

__device__ __forceinline__ void ln_rows(const float* R, const float* gain, const float* bias, float* out) {
    const int lane = threadIdx.x & 63, gw = blockIdx.x * 8 + (threadIdx.x >> 6), GW = gridDim.x * 8;
    for (int row = gw; row < MROWS; row += GW) {
        const float* rp = R + (size_t)row * DM;
        f32x4 v[4]; float s = 0.f;
#pragma unroll
        for (int i = 0; i < 4; ++i) { v[i] = *(const f32x4*)(rp + i * 256 + lane * 4); s += v[i][0] + v[i][1] + v[i][2] + v[i][3]; }
#pragma unroll
        for (int o = 1; o < 64; o <<= 1) s += __shfl_xor(s, o);
        const float mu = s * (1.f / 1024.f);
        float q = 0.f;
#pragma unroll
        for (int i = 0; i < 4; ++i) { v[i] = v[i] - mu; q += v[i][0] * v[i][0] + v[i][1] * v[i][1] + v[i][2] * v[i][2] + v[i][3] * v[i][3]; }
#pragma unroll
        for (int o = 1; o < 64; o <<= 1) q += __shfl_xor(q, o);
        const float rsd = rsqrtf(q * (1.f / 1024.f) + 1e-5f);
#pragma unroll
        for (int i = 0; i < 4; ++i) {
            const f32x4 gv = *(const f32x4*)(gain + i * 256 + lane * 4), bv = *(const f32x4*)(bias + i * 256 + lane * 4);
            *(f32x4*)(out + (size_t)row * DM + i * 256 + lane * 4) = v[i] * rsd * gv + bv;
        }
    }
}

__global__ void __launch_bounds__(NTHREADS, 2) fwd_kernel(Args args) {
    extern __shared__ __attribute__((aligned(16))) unsigned char lds_raw[];
    LAS unsigned char* lds = (LAS unsigned char*)lds_raw;
    unsigned char* ws = args.ws;
    bf16_t* US = (bf16_t*)(ws + WS_US); bf16_t* XB = (bf16_t*)(ws + WS_US); float* R = (float*)(ws + WS_US);
    bf16_t* WIN = (bf16_t*)(ws + WS_WIN); bf16_t* WOUT = (bf16_t*)(ws + WS_WOUT); float* DEC = (float*)(ws + WS_DEC);
    bf16_t* H = (bf16_t*)(ws + WS_H); bf16_t* CAT = (bf16_t*)(ws + WS_CAT);
    const float* x = args.in[0]; const float* w_in = args.in[1]; const float* b_in = args.in[2]; const float* rpb = args.in[3];
    const float* lbf = args.in[4]; const float* lbb = args.in[5]; const float* hgain = args.in[6]; const float* w_out = args.in[7];
    const float* b_out = args.in[8]; const float* ln_g = args.in[9]; const float* ln_b = args.in[10];
    const int G = gridDim.x, bx = blockIdx.x;
    const int vcu = (G % 8 == 0) ? (bx % 8) * (G / 8) + bx / 8 : bx;
    const int lo = args.ph_lo, hi = args.ph_hi;
#define IN(k) (lo <= (k) && (k) < hi)
#define SEAM(k) do { if (args.coop && IN(k) && IN((k) + 1)) cg::this_grid().sync(); } while (0)
    if (IN(0)) p0_convert(x, w_in, w_out, XB, WIN, WOUT);
    SEAM(0);
    if (IN(1)) {
        pg8::Gemm gm{XB, WIN, MROWS, DIN, DM}; pg8::StaticOrder so; so.init(MROWS, DIN, G, vcu);
        EpiH ep{H, b_in};
        pg8::gemm_phase<EpiH, pg8::StaticOrder, true, true>(lds, gm, so, ep);
    }
    SEAM(1);
    if (IN(2)) {
        for (int at = bx; at < 1024; at += G) { const int a2 = (at % 256) * 4 + at / 256; attn_tile(lds, H, rpb, CAT, a2); }
        for (int ht = bx; ht < 1024; ht += G) hgrn_local_tile(lds, H, lbf, lbb, US, DEC, ht);
    }
    SEAM(2);
    if (IN(3)) hgrn_state_scan(US, DEC);
    SEAM(3);
    if (IN(4)) { for (int ht = bx; ht < 1024; ht += G) hgrn_out_tile(lds, H, US, hgain, CAT, ht); }
    SEAM(4);
    if (IN(5)) {
        pg8::Gemm gm{CAT, WOUT, MROWS, DM, DM}; pg8::StaticOrder so; so.init(MROWS, DM, G, vcu);
        EpiR ep{R, b_out, x};
        pg8::gemm_phase<EpiR, pg8::StaticOrder, false, true>(lds, gm, so, ep);
    }
    SEAM(5);
    if (IN(6)) ln_rows(R, ln_g, ln_b, args.out);
#undef IN
#undef SEAM
}

extern "C" void kernel_launch(void* const* d_in, const int* in_sizes, int n_in, void* d_out, int out_size, void* d_ws, size_t ws_size, hipStream_t stream) {
    static int grid = 0;
    if (grid == 0) {
        int dev = 0, cus = 0, per_cu = 0;
        if (hipGetDevice(&dev) != hipSuccess || hipDeviceGetAttribute(&cus, hipDeviceAttributeMultiprocessorCount, dev) != hipSuccess) { fprintf(stderr, "kernel_launch: device query failed\n"); grid = -1; return; }
        if (hipFuncSetAttribute((const void*)fwd_kernel, hipFuncAttributeMaxDynamicSharedMemorySize, LDS_BYTES) != hipSuccess) { fprintf(stderr, "kernel_launch: hipFuncSetAttribute failed\n"); grid = -1; return; }
        if (hipOccupancyMaxActiveBlocksPerMultiprocessor(&per_cu, (const void*)fwd_kernel, NTHREADS, LDS_BYTES) != hipSuccess || per_cu < 1) { fprintf(stderr, "kernel_launch: occupancy query gave %d\n", per_cu); per_cu = 1; }
        (void)hipGetLastError();
        if (per_cu > 1) per_cu = 1;
        grid = cus * per_cu;
        if (ws_size < 256 * MiB) fprintf(stderr, "kernel_launch: workspace too small (%zu)\n", ws_size);
    }
    if (grid < 0) return;
    Args a{};
    for (int i = 0; i < 11; ++i) a.in[i] = (const float*)d_in[i];
    a.out = (float*)d_out; a.ws = (unsigned char*)d_ws;
#if MK_LAUNCHES == 1
    a.ph_lo = 0; a.ph_hi = 7; a.coop = 1;
    void* kargs[] = {&a};
    hipError_t e = hipLaunchCooperativeKernel((const void*)fwd_kernel, dim3(grid), dim3(NTHREADS), kargs, LDS_BYTES, stream);
    if (e != hipSuccess) fprintf(stderr, "cooperative launch failed: %s (grid %d)\n", hipGetErrorString(e), grid);
#else
    for (int p = 0; p < 7; ++p) {
        a.ph_lo = p; a.ph_hi = p + 1; a.coop = 0;
        hipLaunchKernelGGL(fwd_kernel, dim3(grid), dim3(NTHREADS), LDS_BYTES, stream, a);
    }
#endif
}
```

```cpp
#include <hip/hip_runtime.h>
#include <hip/hip_cooperative_groups.h>
#include <cstdio>
#include <cstdint>
namespace cg = cooperative_groups;
#define MK_LAUNCHES 1
namespace pg8 {
#define PG8_LAS __attribute__((address_space(3)))
typedef unsigned short bf16_t;
typedef short bf16x8 __attribute__((ext_vector_type(8)));
typedef float f32x4 __attribute__((ext_vector_type(4)));
typedef unsigned u32x4 __attribute__((ext_vector_type(4)));
constexpr int BM = 256, BK = 64, HALF = 128, HTB = HALF * BK * 2  , STAGE_BYTES = 8 * HTB, NXCD = 8, WGM = 8;

__host__ __device__ __forceinline__ int lds_byte(int r, int c) { const int st = (r >> 4) * 2 + (c >> 5), rr = r & 15, cc = c & 31, ob = rr * 64 + cc * 2; return st * 1024 + (ob ^ (((ob >> 9) & 1) << 5)); }
__host__ __device__ __forceinline__ void stage_rc(int b, int& R, int& C) { const int st = b / 1024, sb = b % 1024, swz = sb ^ (((sb >> 9) & 1) << 5); R = (st >> 1) * 16 + swz / 64; C = (st & 1) * 32 + (swz % 64) / 2; }
__host__ __device__ __forceinline__ int perm32(int rho) { const int n = rho >> 4, i = rho & 15; return 8 * (i >> 2) + 4 * n + (i & 3); }

struct Unit { int pm, pn; };
struct Gemm { const bf16_t* A; const bf16_t* Bt; int M, N, K; };

struct StaticOrder {
    int nM, nN, nwg, G, c;
    __host__ __device__ void init(int M, int N, int G_, int c_) { nM = M / BM; nN = N / BM; nwg = nM * nN; G = G_; c = c_; }
    __host__ __device__ bool next(int i, Unit& u) const {
        const long L = (long)i * G + c; if (L >= nwg) return false;
        int wgid = (int)L; { const int q = nwg / NXCD, r = nwg % NXCD, xcd = wgid % NXCD, off = wgid / NXCD; wgid = (xcd < r ? xcd * (q + 1) : r * (q + 1) + (xcd - r) * q) + off; }
        const int nig = WGM * nN, gid = wgid / nig, fm = gid * WGM, gsz = (nM - fm) < WGM ? (nM - fm) : WGM;
        u.pm = fm + ((wgid % nig) % gsz); u.pn = (wgid % nig) / gsz; return true;
    }
    __device__ __forceinline__ void a_ready(const Unit&) const {}
    __device__ __forceinline__ void done(const Unit&) const {}
};
__device__ __forceinline__ unsigned cvt_pk_bf16(float lo, float hi) { unsigned r; asm volatile("v_cvt_pk_bf16_f32 %0, %1, %2" : "=v"(r) : "v"(lo), "v"(hi)); return r; }
template <class Epi, class Sched, bool ALIGN_EPI = false, bool SP2 = false>
__device__ __forceinline__ void gemm_phase(PG8_LAS unsigned char* lds, const Gemm g, const Sched& S, const Epi& E) {
    const int tid = threadIdx.x, wid = __builtin_amdgcn_readfirstlane(tid >> 6), lane = tid & 63, wr = wid >> 2, wc = wid & 3, fr = lane & 15, fq = lane >> 4;
    const int K = g.K, nt = K / BK;
    unsigned voffA[2], voffB[2];
#pragma unroll
    for (int i = 0; i < 2; ++i) { int R, C; stage_rc(tid * 16 + i * 8192, R, C); const int Rb = Epi::PERM ? ((R & ~31) + perm32(R & 31)) : R;
        voffA[i] = (unsigned)(R * K + C) * 2u; voffB[i] = (unsigned)(Rb * K + C) * 2u; }
    const size_t kstep = (size_t)(BK * 2);
    const size_t hstep = (size_t)HALF * K * 2;
    const size_t tstep = 2 * hstep;
    const unsigned ldsw = (unsigned)wid * 1024u;
    const int aoff = lds_byte(wr * 64 + fr, fq * 8), boff = lds_byte(wc * 32 + fr, fq * 8);
#define PG8_SA(b, h) (((b) * 2 + (h)) * HTB)
#define PG8_SB(b, h) ((4 + (b) * 2 + (h)) * HTB)
#define PG8_STAGE(bufoff, gbase, voff) do { _Pragma("unroll") for (int _i = 0; _i < 2; ++_i) \
        __builtin_amdgcn_global_load_lds((const unsigned*)((const char*)(gbase) + (voff)[_i]), (PG8_LAS unsigned*)(lds + (bufoff) + ldsw + _i * 8192), 16, 0, 0); } while (0)
#define PG8_LDA(dst, b, h) do { _Pragma("unroll") for (int m = 0; m < 4; ++m) _Pragma("unroll") for (int k = 0; k < 2; ++k) dst[m][k] = *(const PG8_LAS bf16x8*)(lds + PG8_SA(b, h) + aoff + m * 2048 + k * 1024); } while (0)
#define PG8_LDB(dst, b, h) do { _Pragma("unroll") for (int n = 0; n < 2; ++n) _Pragma("unroll") for (int k = 0; k < 2; ++k) dst[n][k] = *(const PG8_LAS bf16x8*)(lds + PG8_SB(b, h) + boff + n * 2048 + k * 1024); } while (0)
#define PG8_MMA(ai, bj, At, Bt) do { __builtin_amdgcn_s_setprio(1); _Pragma("unroll") for (int m = 0; m < 4; ++m) _Pragma("unroll") for (int n = 0; n < 2; ++n) _Pragma("unroll") for (int k = 0; k < 2; ++k) \
        acc[ai][bj][m][n] = __builtin_amdgcn_mfma_f32_16x16x32_bf16(Bt[n][k], At[m][k], acc[ai][bj][m][n], 0, 0, 0); __builtin_amdgcn_s_setprio(0); } while (0)
#define PG8_WAIT_V(n) asm volatile("s_waitcnt vmcnt(" #n ")" ::: "memory")
#define PG8_WAIT_L(n) asm volatile("s_waitcnt lgkmcnt(" #n ")" ::: "memory")
#define PG8_BAR __builtin_amdgcn_s_barrier()
#define PG8_SCHED __builtin_amdgcn_sched_barrier(0)
    Unit cur, nxt; int ui = 0;
    if (!S.next(0, cur)) return;
    f32x4 acc[2][2][4][2];
#pragma unroll
    for (int a = 0; a < 2; ++a)
#pragma unroll
        for (int b = 0; b < 2; ++b)
#pragma unroll
            for (int m = 0; m < 4; ++m)
#pragma unroll
                for (int n = 0; n < 2; ++n) acc[a][b][m][n] = (f32x4){0.f, 0.f, 0.f, 0.f};
    bf16x8 At[4][2], B0[2][2], B1[2][2];
    const char* cA = (const char*)g.A + (size_t)cur.pm * tstep; const char* cB = (const char*)g.Bt + (size_t)cur.pn * tstep;
    S.a_ready(cur);
    if constexpr (SP2) {
        PG8_STAGE(PG8_SB(0, 0), cB, voffB); PG8_STAGE(PG8_SB(0, 1), cB + hstep, voffB); PG8_STAGE(PG8_SA(0, 0), cA, voffA); PG8_STAGE(PG8_SA(0, 1), cA + hstep, voffA);
        if (wr == 1) PG8_BAR;
        PG8_WAIT_V(2); PG8_BAR;
        PG8_STAGE(PG8_SB(1, 0), cB + kstep, voffB); PG8_STAGE(PG8_SA(1, 0), cA + kstep, voffA); PG8_STAGE(PG8_SB(1, 1), cB + hstep + kstep, voffB);
        PG8_WAIT_V(6); PG8_BAR;
    } else {
        PG8_STAGE(PG8_SB(0, 0), cB, voffB); PG8_STAGE(PG8_SA(0, 0), cA, voffA); PG8_STAGE(PG8_SB(0, 1), cB + hstep, voffB); PG8_STAGE(PG8_SA(0, 1), cA + hstep, voffA);
        if (wr == 1) PG8_BAR;
        PG8_WAIT_V(4); PG8_BAR;
        PG8_STAGE(PG8_SB(1, 0), cB + kstep, voffB); PG8_STAGE(PG8_SA(1, 0), cA + kstep, voffA); PG8_STAGE(PG8_SB(1, 1), cB + hstep + kstep, voffB);
        PG8_WAIT_V(6); PG8_BAR;
    }
    for (;;) {
        const bool has_next = S.next(ui + 1, nxt);
        const char* nA = has_next ? (const char*)g.A + (size_t)nxt.pm * tstep : cA; const char* nB = has_next ? (const char*)g.Bt + (size_t)nxt.pn * tstep : cB;
        for (int t = 0; t < nt; t += 2) {
            const bool last = (t == nt - 2);
            const char* a1 = cA + (size_t)(t + 1) * kstep;
            const char* a2 = last ? nA : cA + (size_t)(t + 2) * kstep; const char* b2 = last ? nB : cB + (size_t)(t + 2) * kstep;
            const char* a3 = a2 + kstep; const char* b3 = b2 + kstep;
            if (last && has_next) S.a_ready(nxt);
            if constexpr (SP2) {
            PG8_LDB(B0, 0, 0); PG8_LDB(B1, 0, 1); PG8_SCHED; PG8_LDA(At, 0, 0); PG8_STAGE(PG8_SA(1, 1), a1 + hstep, voffA);
            PG8_WAIT_V(8); PG8_WAIT_L(0); PG8_BAR; PG8_MMA(0, 0, At, B0); PG8_MMA(0, 1, At, B1); PG8_BAR; PG8_SCHED;
            PG8_LDA(At, 0, 1); PG8_STAGE(PG8_SB(0, 0), b2, voffB); PG8_STAGE(PG8_SB(0, 1), b2 + hstep, voffB); PG8_STAGE(PG8_SA(0, 0), a2, voffA);
            PG8_WAIT_V(8); PG8_WAIT_L(0); PG8_BAR; PG8_MMA(1, 0, At, B0); PG8_MMA(1, 1, At, B1); PG8_BAR; PG8_SCHED;
            PG8_LDB(B0, 1, 0); PG8_LDB(B1, 1, 1); PG8_SCHED; PG8_LDA(At, 1, 0); PG8_STAGE(PG8_SA(0, 1), a2 + hstep, voffA);
            PG8_WAIT_V(8); PG8_WAIT_L(0); PG8_BAR; PG8_MMA(0, 0, At, B0); PG8_MMA(0, 1, At, B1); PG8_BAR; PG8_SCHED;
            PG8_LDA(At, 1, 1); PG8_STAGE(PG8_SB(1, 0), b3, voffB); PG8_STAGE(PG8_SB(1, 1), b3 + hstep, voffB); PG8_STAGE(PG8_SA(1, 0), a3, voffA);
            PG8_WAIT_V(8); PG8_WAIT_L(0); PG8_BAR; PG8_MMA(1, 0, At, B0); PG8_MMA(1, 1, At, B1); PG8_BAR; PG8_SCHED;
            } else {
            PG8_LDB(B0, 0, 0); PG8_SCHED; PG8_LDA(At, 0, 0); PG8_STAGE(PG8_SA(1, 1), a1 + hstep, voffA);
            PG8_WAIT_L(8); PG8_BAR; PG8_WAIT_L(0); PG8_MMA(0, 0, At, B0); PG8_BAR; PG8_SCHED;
            PG8_LDB(B1, 0, 1); PG8_STAGE(PG8_SB(0, 0), b2, voffB);
            PG8_BAR; PG8_WAIT_L(0); PG8_MMA(0, 1, At, B1); PG8_BAR;
            PG8_LDA(At, 0, 1); PG8_STAGE(PG8_SA(0, 0), a2, voffA);
            PG8_BAR; PG8_WAIT_L(0); PG8_MMA(1, 0, At, B0); PG8_BAR; PG8_SCHED;
            PG8_STAGE(PG8_SB(0, 1), b2 + hstep, voffB);
            PG8_WAIT_V(6); PG8_BAR; PG8_MMA(1, 1, At, B1); PG8_BAR;
            PG8_LDB(B0, 1, 0); PG8_SCHED; PG8_LDA(At, 1, 0); PG8_STAGE(PG8_SA(0, 1), a2 + hstep, voffA);
            PG8_WAIT_L(8); PG8_BAR; PG8_WAIT_L(0); PG8_MMA(0, 0, At, B0); PG8_BAR; PG8_SCHED;
            PG8_LDB(B1, 1, 1); PG8_STAGE(PG8_SB(1, 0), b3, voffB);
            PG8_BAR; PG8_WAIT_L(0); PG8_MMA(0, 1, At, B1); PG8_BAR;
            PG8_LDA(At, 1, 1); PG8_STAGE(PG8_SA(1, 0), a3, voffA);
            PG8_BAR; PG8_WAIT_L(0); PG8_MMA(1, 0, At, B0); PG8_BAR; PG8_SCHED;
            PG8_STAGE(PG8_SB(1, 1), b3 + hstep, voffB);
            PG8_WAIT_V(6); PG8_BAR; PG8_MMA(1, 1, At, B1); PG8_BAR;
            }
        }
        if constexpr (ALIGN_EPI) { if (wr == 0) PG8_BAR; }
        if constexpr (!Epi::AFTER_DRAIN) { E(acc, cur, wr, wc, fr, fq); S.done(cur); }
        if (!has_next) break;
#pragma unroll
        for (int a = 0; a < 2; ++a)
#pragma unroll
            for (int b = 0; b < 2; ++b)
#pragma unroll
                for (int m = 0; m < 4; ++m)
#pragma unroll
                    for (int n = 0; n < 2; ++n) acc[a][b][m][n] = (f32x4){0.f, 0.f, 0.f, 0.f};
        cur = nxt; cA = nA; cB = nB; ++ui;
        if constexpr (ALIGN_EPI) { if (wr == 1) PG8_BAR; }
    }
    PG8_WAIT_V(0);
    if constexpr (!ALIGN_EPI) { if (wr == 0) PG8_BAR; }
    PG8_BAR;
    if constexpr (Epi::AFTER_DRAIN) { E.fused(acc, cur, wr, wc, fr, fq, lds, wid, lane); S.done(cur); }
#undef PG8_SA
#undef PG8_SB
#undef PG8_STAGE
#undef PG8_LDA
#undef PG8_LDB
#undef PG8_MMA
#undef PG8_WAIT_V
#undef PG8_WAIT_L
#undef PG8_BAR
#undef PG8_SCHED
}
}

#ifndef MK_LAUNCHES
#define MK_LAUNCHES 1
#endif
#define LAS __attribute__((address_space(3)))
typedef unsigned short bf16_t;
typedef short bf16x8 __attribute__((ext_vector_type(8)));
typedef float f32x4 __attribute__((ext_vector_type(4)));
typedef unsigned u32x4 __attribute__((ext_vector_type(4)));
typedef unsigned u32x2 __attribute__((ext_vector_type(2)));

constexpr int NTHREADS = 512;
constexpr int BATCH = 2, SEQ = 8192, DM = 1024, MROWS = BATCH * SEQ, DIN = 4608;
constexpr int C_QA = 0, C_KA = 512, C_VA = 1024, C_GA = 1536, C_QH = 2048, C_ZF = 2560, C_ZB = 3072, C_IH = 3584, C_GH = 4096;
constexpr float ALPHA = 1.189207115002721f;
constexpr size_t MiB = 1u << 20;
constexpr size_t WS_US = 0;
constexpr size_t WS_WIN = 64 * MiB, WS_WOUT = 73 * MiB, WS_DEC = 75 * MiB, WS_CTL = 77 * MiB;
constexpr size_t WS_H = 80 * MiB;
constexpr size_t WS_CAT = 224 * MiB;
constexpr int LDS_BYTES = 158720;

struct Args { const float* in[11]; float* out; unsigned char* ws; int ph_lo, ph_hi, coop, pad; };

__device__ __forceinline__ float bf2f(unsigned v) { return __builtin_bit_cast(float, v << 16); }
__device__ __forceinline__ unsigned f2bf(float f) { unsigned u = __builtin_bit_cast(unsigned, f); return (u + 0x7fffu + ((u >> 16) & 1u)) >> 16; }
__device__ __forceinline__ unsigned pk2(float lo, float hi) { return pg8::cvt_pk_bf16(lo, hi); }
__device__ __forceinline__ float sigmoidf_(float z) { return 1.f / (1.f + __expf(-z)); }
__device__ __forceinline__ float siluf_(float z) { return z / (1.f + __expf(-z)); }
__device__ __forceinline__ bf16x8 as_bf16x8(u32x4 v) { return __builtin_bit_cast(bf16x8, v); }

struct EpiH {
    static constexpr bool PERM = true, AFTER_DRAIN = false;
    bf16_t* O; const float* bias;
    __device__ __forceinline__ void operator()(const f32x4 (&acc)[2][2][4][2], const pg8::Unit& u, int wr, int wc, int fr, int fq) const {
        const int row0 = u.pm * 256 + wr * 64 + fr, col0 = u.pn * 256 + wc * 32 + 8 * fq;
        f32x4 bv[2][2];
#pragma unroll
        for (int bj = 0; bj < 2; ++bj)
#pragma unroll
            for (int n = 0; n < 2; ++n) bv[bj][n] = *(const f32x4*)(bias + col0 + bj * 128 + 4 * n);
#pragma unroll
        for (int ai = 0; ai < 2; ++ai)
#pragma unroll
            for (int m = 0; m < 4; ++m) { bf16_t* rowp = O + (size_t)(row0 + ai * 128 + m * 16) * DIN + col0;
#pragma unroll
                for (int bj = 0; bj < 2; ++bj) { f32x4 v0 = acc[ai][bj][m][0] + bv[bj][0], v1 = acc[ai][bj][m][1] + bv[bj][1];
                    u32x4 w; w.x = pk2(v0[0], v0[1]); w.y = pk2(v0[2], v0[3]); w.z = pk2(v1[0], v1[1]); w.w = pk2(v1[2], v1[3]);
                    *(u32x4*)(rowp + bj * 128) = w; } }
    }
};
struct EpiR {
    static constexpr bool PERM = false, AFTER_DRAIN = false;
    float* R; const float* bias; const float* x;
    __device__ __forceinline__ void operator()(const f32x4 (&acc)[2][2][4][2], const pg8::Unit& u, int wr, int wc, int fr, int fq) const {
        const int row0 = u.pm * 256 + wr * 64 + fr, col0 = u.pn * 256 + wc * 32 + 4 * fq;
        f32x4 bv[2][2];
#pragma unroll
        for (int bj = 0; bj < 2; ++bj)
#pragma unroll
            for (int n = 0; n < 2; ++n) bv[bj][n] = *(const f32x4*)(bias + col0 + bj * 128 + n * 16);
#pragma unroll
        for (int ai = 0; ai < 2; ++ai)
#pragma unroll
            for (int m = 0; m < 4; ++m) { const size_t ro = (size_t)(row0 + ai * 128 + m * 16) * DM + col0;
#pragma unroll
                for (int bj = 0; bj < 2; ++bj)
#pragma unroll
                    for (int n = 0; n < 2; ++n) { const f32x4 xv = *(const f32x4*)(x + ro + bj * 128 + n * 16);
                        *(f32x4*)(R + ro + bj * 128 + n * 16) = acc[ai][bj][m][n] + bv[bj][n] + xv * ALPHA; } }
    }
};

__device__ __forceinline__ void p0_convert(const float* x, const float* w_in, const float* w_out, bf16_t* XB, bf16_t* WIN, bf16_t* WOUT) {
    const int gt = blockIdx.x * NTHREADS + threadIdx.x, GT = gridDim.x * NTHREADS;
    for (int i = gt; i < MROWS * DM / 8; i += 4 * GT) {
        f32x4 a[4], b[4];
#pragma unroll
        for (int k = 0; k < 4; ++k) if (i + k * GT < MROWS * DM / 8) { const size_t o = (size_t)(i + k * GT) * 8; a[k] = __builtin_nontemporal_load((const f32x4*)(x + o)); b[k] = __builtin_nontemporal_load((const f32x4*)(x + o + 4)); }
#pragma unroll
        for (int k = 0; k < 4; ++k) if (i + k * GT < MROWS * DM / 8) { u32x4 w; w.x = pk2(a[k][0], a[k][1]); w.y = pk2(a[k][2], a[k][3]); w.z = pk2(b[k][0], b[k][1]); w.w = pk2(b[k][2], b[k][3]);
            *(u32x4*)(XB + (size_t)(i + k * GT) * 8) = w; }
    }
    for (int i = gt; i < DIN * 128; i += GT) {
        const int n = i % DIN, kb = i / DIN; float v[8];
#pragma unroll
        for (int j = 0; j < 8; ++j) v[j] = w_in[(size_t)(kb * 8 + j) * DIN + n];
        u32x4 w; w.x = pk2(v[0], v[1]); w.y = pk2(v[2], v[3]); w.z = pk2(v[4], v[5]); w.w = pk2(v[6], v[7]);
        *(u32x4*)(WIN + (size_t)n * 1024 + kb * 8) = w;
    }
    for (int i = gt; i < DM * 128; i += GT) {
        const int n = i % DM, kb = i / DM; float v[8];
#pragma unroll
        for (int j = 0; j < 8; ++j) v[j] = w_out[(size_t)(kb * 8 + j) * DM + n];
        u32x4 w; w.x = pk2(v[0], v[1]); w.y = pk2(v[2], v[3]); w.z = pk2(v[4], v[5]); w.w = pk2(v[6], v[7]);
        *(u32x4*)(WOUT + (size_t)n * 1024 + kb * 8) = w;
    }
}

constexpr int AT_VP = 520;
constexpr int AT_RPB_OFF = 2 * 64 * AT_VP * 2;
__device__ __forceinline__ void attn_tile(LAS unsigned char* lds, const bf16_t* H, const float* rpb, bf16_t* CAT, int at) {
    const int tid = threadIdx.x, lane = tid & 63, w = tid >> 6, fr = lane & 15, g = lane >> 4;
    const int b = at >> 9, hp = (at >> 7) & 3, r = at & 127;
    int rs = r - 4; rs = rs < 0 ? 0 : (rs > 120 ? 120 : rs);
    LAS bf16_t* VT = (LAS bf16_t*)lds;
    LAS float* RPB = (LAS float*)(lds + AT_RPB_OFF);
    {
        const size_t tok = (size_t)b * SEQ + (size_t)(rs + (tid >> 6)) * 64 + (tid & 63);
#pragma unroll
        for (int hh = 0; hh < 2; ++hh) {
            const bf16_t* src = H + tok * DIN + C_VA + (2 * hp + hh) * 64;
#pragma unroll
            for (int p = 0; p < 8; ++p) {
                const u32x4 v = *(const u32x4*)(src + 8 * p);
#pragma unroll
                for (int i = 0; i < 4; ++i) {
                    VT[(hh * 64 + 8 * p + 2 * i) * AT_VP + tid] = (bf16_t)(v[i] & 0xffffu);
                    VT[(hh * 64 + 8 * p + 2 * i + 1) * AT_VP + tid] = (bf16_t)(v[i] >> 16);
                }
            }
        }
        for (int i = tid; i < 930; i += NTHREADS) RPB[i] = rpb[hp * 930 + i];
    }
    __syncthreads();
    const int hh = w >> 2, j = w & 3, head = 2 * hp + hh;
    const int kc0 = (j == 0) ? 0 : (j == 1 ? 8 : (j == 2 ? 24 : 32));
    const size_t qtok = (size_t)b * SEQ + (size_t)r * 64 + 16 * j + fr;
    bf16x8 qf[2];
#pragma unroll
    for (int ks = 0; ks < 2; ++ks) qf[ks] = as_bf16x8(*(const u32x4*)(H + qtok * DIN + C_QA + head * 64 + ks * 32 + 8 * g));
    f32x4 S[16];
#pragma unroll
    for (int kt = 0; kt < 16; ++kt) {
        const int a = kt >> 1, ch = kt & 1;
        const size_t ktok = (size_t)b * SEQ + (size_t)(rs + a) * 64 + kc0 + 16 * ch + fr;
        const bf16_t* kp = H + ktok * DIN + C_KA + head * 64 + 8 * g;
        const bf16x8 k0 = as_bf16x8(*(const u32x4*)(kp)), k1 = as_bf16x8(*(const u32x4*)(kp + 32));
        f32x4 acc = {0.f, 0.f, 0.f, 0.f};
        acc = __builtin_amdgcn_mfma_f32_16x16x32_bf16(k0, qf[0], acc, 0, 0, 0);
        acc = __builtin_amdgcn_mfma_f32_16x16x32_bf16(k1, qf[1], acc, 0, 0, 0);
        S[kt] = acc;
    }
    const int qcol = 16 * j + fr;
    int cs = qcol - 8; cs = cs < 0 ? 0 : (cs > 48 ? 48 : cs);
    float mx = -1e30f;
#pragma unroll
    for (int kt = 0; kt < 16; ++kt) {
        const int a = kt >> 1, ch = kt & 1;
        const int dr = rs + a - r + 7;
#pragma unroll
        for (int rg = 0; rg < 4; ++rg) {
            const int kcol = kc0 + 16 * ch + 4 * g + rg;
            int dc = kcol - qcol + 15; dc = dc < 0 ? 0 : (dc > 30 ? 30 : dc);
            const bool inw = (unsigned)(kcol - cs) < 16u;
            const float s = S[kt][rg] * 0.125f + RPB[hh * 465 + dr * 31 + dc];
            S[kt][rg] = inw ? s : -1e30f;
            mx = fmaxf(mx, S[kt][rg]);
        }
    }
    mx = fmaxf(mx, __shfl_xor(mx, 16)); mx = fmaxf(mx, __shfl_xor(mx, 32));
    float sum = 0.f;
#pragma unroll
    for (int kt = 0; kt < 16; ++kt)
#pragma unroll
        for (int rg = 0; rg < 4; ++rg) { const float p = __expf(S[kt][rg] - mx); S[kt][rg] = p; sum += p; }
    sum += __shfl_xor(sum, 16); sum += __shfl_xor(sum, 32);
    f32x4 O[4];
#pragma unroll
    for (int mt = 0; mt < 4; ++mt) O[mt] = (f32x4){0.f, 0.f, 0.f, 0.f};
#pragma unroll
    for (int kk = 0; kk < 8; ++kk) {
        u32x4 pw; pw.x = pk2(S[2 * kk][0], S[2 * kk][1]); pw.y = pk2(S[2 * kk][2], S[2 * kk][3]);
        pw.z = pk2(S[2 * kk + 1][0], S[2 * kk + 1][1]); pw.w = pk2(S[2 * kk + 1][2], S[2 * kk + 1][3]);
        const bf16x8 pf = as_bf16x8(pw);
        const int key1 = kk * 64 + kc0 + 4 * g;
#pragma unroll
        for (int mt = 0; mt < 4; ++mt) {
            const LAS bf16_t* vp = VT + (hh * 64 + 16 * mt + fr) * AT_VP + key1;
            const u32x2 lo = *(const LAS u32x2*)(vp), hi = *(const LAS u32x2*)(vp + 16);
            u32x4 vw; vw.x = lo.x; vw.y = lo.y; vw.z = hi.x; vw.w = hi.y;
            O[mt] = __builtin_amdgcn_mfma_f32_16x16x32_bf16(as_bf16x8(vw), pf, O[mt], 0, 0, 0);
        }
    }
    const float inv = 1.f / sum;
#pragma unroll
    for (int mt = 0; mt < 4; ++mt) {
        const int e = 16 * mt + 4 * g;
        const u32x2 gw = *(const u32x2*)(H + qtok * DIN + C_GA + head * 64 + e);
        const float g0 = bf2f(gw.x & 0xffffu), g1 = bf2f(gw.x >> 16), g2 = bf2f(gw.y & 0xffffu), g3 = bf2f(gw.y >> 16);
        u32x2 ow; ow.x = pk2(O[mt][0] * inv * siluf_(g0), O[mt][1] * inv * siluf_(g1)); ow.y = pk2(O[mt][2] * inv * siluf_(g2), O[mt][3] * inv * siluf_(g3));
        *(u32x2*)(CAT + qtok * DM + head * 64 + e) = ow;
    }
    __syncthreads();
}

constexpr int HG_QS = 0, HG_VT = 16384, HG_LF = 34816, HG_ZS = 67584, HG_QT = 83968, HG_KP = 101376, HG_KPT = 118784, HG_TOT = 137216, HG_DECS = 139264;
constexpr int HG_VP = 72, HG_QP = 136;
__device__ __forceinline__ void hgrn_local_tile(LAS unsigned char* lds, bf16_t* H, const float* lbf, const float* lbb, bf16_t* US, float* DEC, int ht) {
    const int tid = threadIdx.x, lane = tid & 63, w = tid >> 6, fr = lane & 15, g = lane >> 4;
    const int b = ht >> 9, h = (ht >> 7) & 3, c = ht & 127;
    const size_t tok0 = (size_t)b * SEQ + (size_t)c * 64;
    LAS bf16_t* QS = (LAS bf16_t*)(lds + HG_QS); LAS bf16_t* VT = (LAS bf16_t*)(lds + HG_VT); LAS float* LF = (LAS float*)(lds + HG_LF);
    LAS bf16_t* ZS = (LAS bf16_t*)(lds + HG_ZS); LAS bf16_t* QT = (LAS bf16_t*)(lds + HG_QT); LAS bf16_t* KP = (LAS bf16_t*)(lds + HG_KP);
    LAS bf16_t* KPT = (LAS bf16_t*)(lds + HG_KPT); LAS float* TOT = (LAS float*)(lds + HG_TOT); LAS float* DECS = (LAS float*)(lds + HG_DECS);
#pragma unroll
    for (int i = 0; i < 2; ++i) {
        const int p = tid + i * NTHREADS, s = p >> 4, d8 = (p & 15) * 8;
        const bf16_t* rowp = H + (tok0 + s) * DIN + h * 128 + d8;
        *(LAS u32x4*)(QS + s * 128 + d8) = *(const u32x4*)(rowp + C_QH);
        const u32x4 v = *(const u32x4*)(rowp + C_IH);
#pragma unroll
        for (int k = 0; k < 4; ++k) { VT[(d8 + 2 * k) * HG_VP + s] = (bf16_t)(v[k] & 0xffffu); VT[(d8 + 2 * k + 1) * HG_VP + s] = (bf16_t)(v[k] >> 16); }
    }
    const int d = tid & 127, sq = tid >> 7;
    const int tt = w & 3, eh = w >> 2;
    f32x4 OI[4];
#pragma unroll
    for (int nt = 0; nt < 4; ++nt) OI[nt] = (f32x4){0.f, 0.f, 0.f, 0.f};
    for (int dir = 0; dir < 2; ++dir) {
        const float* lbl = dir ? lbb : lbf;
        const float lb = 1.f / (1.f + __expf(lbl[512 + h * 128 + d] - lbl[h * 128 + d]));
        const int zc = dir ? C_ZB : C_ZF;
#pragma unroll
        for (int i = 0; i < 2; ++i) {
            const int p = tid + i * NTHREADS, s = p >> 4, d8 = (p & 15) * 8;
            *(LAS u32x4*)(ZS + s * 128 + d8) = *(const u32x4*)(H + (tok0 + s) * DIN + zc + h * 128 + d8);
        }
        __syncthreads();
        float kreg[16];
#pragma unroll
        for (int i = 0; i < 16; ++i) {
            const int s = sq + 4 * i;
            const float z = bf2f(ZS[s * 128 + d]);
            const float ez = __expf(-z), sg = 1.f / (1.f + ez);
            const float f = lb + (1.f - lb) * sg;
            LF[s * 128 + d] = __logf(f);
            kreg[i] = (1.f - lb) * (1.f - sg);
        }
        __syncthreads();
        {
            float run = 0.f;
#pragma unroll
            for (int i = 0; i < 16; ++i) {
                const int s = dir ? (16 * sq + 15 - i) : (16 * sq + i);
                run += LF[s * 128 + d]; LF[s * 128 + d] = run;
            }
            TOT[sq * 128 + d] = run;
        }
        __syncthreads();
        {
            const float t0 = TOT[d], t1 = TOT[128 + d], t2 = TOT[256 + d], t3 = TOT[384 + d];
            float pre[4];
            if (dir == 0) { pre[0] = 0.f; pre[1] = t0; pre[2] = t0 + t1; pre[3] = t0 + t1 + t2; }
            else          { pre[3] = 0.f; pre[2] = t3; pre[1] = t3 + t2; pre[0] = t3 + t2 + t1; }
            if (tid < 128) { const float dec = __expf(t0 + t1 + t2 + t3); DECS[d] = dec; DEC[((size_t)((dir * 8 + b * 4 + h) * 128 + c)) * 128 + d] = dec; }
#pragma unroll
            for (int i = 0; i < 16; ++i) {
                const int s = sq + 4 * i;
                const float bb = LF[s * 128 + d] + pre[i >> 2];
                const float eq = __expf(bb), ek = __expf(-bb);
                const float qv = bf2f(QS[s * 128 + d]);
                const bf16_t qt = (bf16_t)f2bf(qv * eq), kp = (bf16_t)f2bf(kreg[i] * ek);
                QT[s * HG_QP + d] = qt; KP[s * HG_QP + d] = kp; KPT[d * HG_VP + s] = kp;
            }
        }
        __syncthreads();
        {
            f32x4 aT[4];
#pragma unroll
            for (int st = 0; st < 4; ++st) {
                f32x4 acc = {0.f, 0.f, 0.f, 0.f};
                const bool live = dir ? (st >= tt) : (st <= tt);
                if (live) {
#pragma unroll
                    for (int ks = 0; ks < 4; ++ks) {
                        const bf16x8 af = *(const LAS bf16x8*)(KP + (16 * st + fr) * HG_QP + 32 * ks + 8 * g);
                        const bf16x8 bfr = *(const LAS bf16x8*)(QT + (16 * tt + fr) * HG_QP + 32 * ks + 8 * g);
                        acc = __builtin_amdgcn_mfma_f32_16x16x32_bf16(af, bfr, acc, 0, 0, 0);
                    }
                    const int t = 16 * tt + fr;
#pragma unroll
                    for (int rg = 0; rg < 4; ++rg) { const int s = 16 * st + 4 * g + rg; const bool keep = dir ? (s >= t) : (s <= t); acc[rg] = keep ? acc[rg] : 0.f; }
                }
                aT[st] = acc;
            }
#pragma unroll
            for (int kk = 0; kk < 2; ++kk) {
                u32x4 aw; aw.x = pk2(aT[2 * kk][0], aT[2 * kk][1]); aw.y = pk2(aT[2 * kk][2], aT[2 * kk][3]);
                aw.z = pk2(aT[2 * kk + 1][0], aT[2 * kk + 1][1]); aw.w = pk2(aT[2 * kk + 1][2], aT[2 * kk + 1][3]);
                const bf16x8 af = as_bf16x8(aw);
#pragma unroll
                for (int nt = 0; nt < 4; ++nt) {
                    const LAS bf16_t* vp = VT + (64 * eh + 16 * nt + fr) * HG_VP + 32 * kk + 4 * g;
                    const u32x2 lo = *(const LAS u32x2*)(vp), hi = *(const LAS u32x2*)(vp + 16);
                    u32x4 vw; vw.x = lo.x; vw.y = lo.y; vw.z = hi.x; vw.w = hi.y;
                    OI[nt] = __builtin_amdgcn_mfma_f32_16x16x32_bf16(af, as_bf16x8(vw), OI[nt], 0, 0, 0);
                }
            }
        }
        {
            const bf16x8 va0 = *(const LAS bf16x8*)(VT + (16 * w + fr) * HG_VP + 8 * g), va1 = *(const LAS bf16x8*)(VT + (16 * w + fr) * HG_VP + 32 + 8 * g);
            bf16_t* up = US + ((size_t)((dir * 8 + b * 4 + h) * 128 + c)) * 16384;
#pragma unroll
            for (int dt = 0; dt < 8; ++dt) {
                const bf16x8 kb0 = *(const LAS bf16x8*)(KPT + (16 * dt + fr) * HG_VP + 8 * g), kb1 = *(const LAS bf16x8*)(KPT + (16 * dt + fr) * HG_VP + 32 + 8 * g);
                f32x4 acc = {0.f, 0.f, 0.f, 0.f};
                acc = __builtin_amdgcn_mfma_f32_16x16x32_bf16(va0, kb0, acc, 0, 0, 0);
                acc = __builtin_amdgcn_mfma_f32_16x16x32_bf16(va1, kb1, acc, 0, 0, 0);
                const float dec = DECS[16 * dt + fr];
#pragma unroll
                for (int rg = 0; rg < 4; ++rg) up[(16 * w + 4 * g + rg) * 128 + 16 * dt + fr] = (bf16_t)f2bf(acc[rg] * dec);
            }
        }
#pragma unroll
        for (int i = 0; i < 2; ++i) {
            const int p = tid + i * NTHREADS, s = p >> 4, d8 = (p & 15) * 8;
            *(u32x4*)(H + (tok0 + s) * DIN + zc + h * 128 + d8) = *(const LAS u32x4*)(QT + s * HG_QP + d8);
        }
        __syncthreads();
    }
#pragma unroll
    for (int nt = 0; nt < 4; ++nt)
#pragma unroll
        for (int rg = 0; rg < 4; ++rg)
            H[(tok0 + 16 * tt + 4 * g + rg) * DIN + C_QH + h * 128 + 64 * eh + 16 * nt + fr] = (bf16_t)f2bf(OI[nt][rg]);
}

__device__ __forceinline__ void hgrn_state_scan(bf16_t* US, const float* DEC, int dry) {
    const int gt = blockIdx.x * NTHREADS + threadIdx.x, GT = gridDim.x * NTHREADS;
    for (int it = gt; it < 16 * 8192; it += GT) {
        const int sidx = it >> 13, rem = (it & 8191) * 2, d = rem & 127, dir = sidx >> 3;
        float s0 = 0.f, s1 = 0.f;
        for (int c0 = 0; c0 < 128; c0 += 8) {
            unsigned u[8]; float2 dc[8];
#pragma unroll
            for (int k = 0; k < 8; ++k) {
                const int c = dir ? (127 - c0 - k) : (c0 + k);
                u[k] = *(const unsigned*)(US + ((size_t)(sidx * 128 + c)) * 16384 + rem);
                dc[k] = *(const float2*)(DEC + ((size_t)(sidx * 128 + c)) * 128 + d);
            }
#pragma unroll
            for (int k = 0; k < 8; ++k) {
                const int c = dir ? (127 - c0 - k) : (c0 + k);
                *(unsigned*)(US + ((size_t)(sidx * 128 + c)) * 16384 + rem) = dry ? u[k] : pk2(s0, s1);
                s0 = dc[k].x * s0 + bf2f(u[k] & 0xffffu); s1 = dc[k].y * s1 + bf2f(u[k] >> 16);
            }
        }
    }
}

__device__ __forceinline__ void hgrn_out_tile(LAS unsigned char* lds, const bf16_t* H, const bf16_t* US, const float* gain, bf16_t* CAT, int ht) {
    const int tid = threadIdx.x, lane = tid & 63, w = tid >> 6, fr = lane & 15, g = lane >> 4;
    const int b = ht >> 9, h = (ht >> 7) & 3, c = ht & 127;
    const size_t tok0 = (size_t)b * SEQ + (size_t)c * 64;
    const int tt = w & 3, eh = w >> 2;
    LAS float* SSQ = (LAS float*)lds;
    f32x4 acc[4];
#pragma unroll
    for (int nt = 0; nt < 4; ++nt) acc[nt] = (f32x4){0.f, 0.f, 0.f, 0.f};
#pragma unroll
    for (int dir = 0; dir < 2; ++dir) {
        const bf16_t* qp = H + (tok0 + 16 * tt + fr) * DIN + (dir ? C_ZB : C_ZF) + h * 128 + 8 * g;
        const bf16_t* sp = US + ((size_t)((dir * 8 + b * 4 + h) * 128 + c)) * 16384 + 8 * g;
        bf16x8 qa[4];
#pragma unroll
        for (int ks = 0; ks < 4; ++ks) qa[ks] = as_bf16x8(*(const u32x4*)(qp + 32 * ks));
#pragma unroll
        for (int nt = 0; nt < 4; ++nt)
#pragma unroll
            for (int ks = 0; ks < 4; ++ks) {
                const bf16x8 sb = as_bf16x8(*(const u32x4*)(sp + (64 * eh + 16 * nt + fr) * 128 + 32 * ks));
                acc[nt] = __builtin_amdgcn_mfma_f32_16x16x32_bf16(qa[ks], sb, acc[nt], 0, 0, 0);
            }
    }
    float ssq[4] = {0.f, 0.f, 0.f, 0.f};
#pragma unroll
    for (int nt = 0; nt < 4; ++nt)
#pragma unroll
        for (int rg = 0; rg < 4; ++rg) {
            acc[nt][rg] += bf2f(H[(tok0 + 16 * tt + 4 * g + rg) * DIN + C_QH + h * 128 + 64 * eh + 16 * nt + fr]);
            ssq[rg] += acc[nt][rg] * acc[nt][rg];
        }
#pragma unroll
    for (int rg = 0; rg < 4; ++rg) {
        float v = ssq[rg];
        v += __shfl_xor(v, 1); v += __shfl_xor(v, 2); v += __shfl_xor(v, 4); v += __shfl_xor(v, 8);
        ssq[rg] = v;
    }
    if (fr == 0) {
#pragma unroll
        for (int rg = 0; rg < 4; ++rg) SSQ[eh * 64 + 16 * tt + 4 * g + rg] = ssq[rg];
    }
    __syncthreads();
#pragma unroll
    for (int rg = 0; rg < 4; ++rg) {
        const int t = 16 * tt + 4 * g + rg;
        const float rsn = rsqrtf((SSQ[t] + SSQ[64 + t]) * (1.f / 128.f) + 1e-6f);
#pragma unroll
        for (int nt = 0; nt < 4; ++nt) {
            const int e = h * 128 + 64 * eh + 16 * nt + fr;
            const float gh = bf2f(H[(tok0 + t) * DIN + C_GH + e]);
            CAT[(tok0 + t) * DM + 512 + e] = (bf16_t)f2bf(acc[nt][rg] * rsn * gain[e] * siluf_(gh));
        }
    }
    __syncthreads();
}

__device__ __forceinline__ void ln_rows(const float* R, const float* gain, const float* bias, float* out) {
    const int lane = threadIdx.x & 63, gw = blockIdx.x * 8 + (threadIdx.x >> 6), GW = gridDim.x * 8;
    f32x4 gv[4], bv[4];
#pragma unroll
    for (int i = 0; i < 4; ++i) { gv[i] = *(const f32x4*)(gain + i * 256 + lane * 4); bv[i] = *(const f32x4*)(bias + i * 256 + lane * 4); }
    for (int row0 = gw * 4; row0 < MROWS; row0 += GW * 4) {
        f32x4 v[4][4]; float s[4], q[4];
#pragma unroll
        for (int r = 0; r < 4; ++r)
#pragma unroll
            for (int i = 0; i < 4; ++i) v[r][i] = *(const f32x4*)(R + (size_t)(row0 + r) * DM + i * 256 + lane * 4);
#pragma unroll
        for (int r = 0; r < 4; ++r) { s[r] = 0.f;
#pragma unroll
            for (int i = 0; i < 4; ++i) s[r] += v[r][i][0] + v[r][i][1] + v[r][i][2] + v[r][i][3]; }
#pragma unroll
        for (int o = 1; o < 64; o <<= 1)
#pragma unroll
            for (int r = 0; r < 4; ++r) s[r] += __shfl_xor(s[r], o);
#pragma unroll
        for (int r = 0; r < 4; ++r) { const float mu = s[r] * (1.f / 1024.f); q[r] = 0.f;
#pragma unroll
            for (int i = 0; i < 4; ++i) { v[r][i] = v[r][i] - mu; q[r] += v[r][i][0] * v[r][i][0] + v[r][i][1] * v[r][i][1] + v[r][i][2] * v[r][i][2] + v[r][i][3] * v[r][i][3]; } }
#pragma unroll
        for (int o = 1; o < 64; o <<= 1)
#pragma unroll
            for (int r = 0; r < 4; ++r) q[r] += __shfl_xor(q[r], o);
#pragma unroll
        for (int r = 0; r < 4; ++r) { const float rsd = rsqrtf(q[r] * (1.f / 1024.f) + 1e-5f);
#pragma unroll
            for (int i = 0; i < 4; ++i) __builtin_nontemporal_store(v[r][i] * rsd * gv[i] + bv[i], (f32x4*)(out + (size_t)(row0 + r) * DM + i * 256 + lane * 4)); }
    }
}

#define XB_TMO      128
#define XB_XCNT(j)  (256  + 64 * (j))
#define XB_XSUB(j)  (1280 + 64 * (j))
#define XB_XGEN(j)  (2304 + 64 * (j))
#define XB_TOP      3328
#define XB_TOPGEN   3392
#define XCD_BAR_WORDS 3456
#define XB_SPIN_CAP (1u << 18)
__device__ __forceinline__ unsigned xb_ld(unsigned* p)              { return __hip_atomic_load(p, __ATOMIC_RELAXED, __HIP_MEMORY_SCOPE_AGENT); }
__device__ __forceinline__ unsigned xb_add(unsigned* p, unsigned v) { return __hip_atomic_fetch_add(p, v, __ATOMIC_RELAXED, __HIP_MEMORY_SCOPE_AGENT); }
__device__ __forceinline__ unsigned xb_xcc_id() { return (unsigned)__builtin_amdgcn_s_getreg((3 << 11) | 20) & 0xFu; }
#define XB_SPIN(cond, bar) do { unsigned _sp = 0; while (cond) { __builtin_amdgcn_s_sleep(1); \
    if ((++_sp & 255u) == 0u) { if (xb_ld(&(bar)[XB_TMO])) break; if (_sp > XB_SPIN_CAP) { atomicAdd(&(bar)[XB_TMO], 1u); break; } } } } while (0)
struct XcdBarrier { unsigned* bar; unsigned x; volatile LAS unsigned* st; };
__device__ __forceinline__ XcdBarrier xcd_barrier_post(unsigned* bar, volatile LAS unsigned* st) {
    XcdBarrier b; b.bar = bar; b.x = xb_xcc_id(); b.st = st;
    if (threadIdx.x == 0) (void)xb_add(&bar[XB_XCNT(b.x)], 1u);
    return b;
}
__device__ __forceinline__ void xcd_barrier_complete(unsigned* bar, unsigned x, unsigned& nloc, unsigned& nx) {
    const unsigned G = gridDim.x * gridDim.y * gridDim.z;
    unsigned sum, cnt, mine, sp = 0u;
    for (;;) {
        sum = 0u; cnt = 0u; mine = 0u;
#pragma unroll
        for (unsigned j = 0; j < 16; ++j) { const unsigned c = xb_ld(&bar[XB_XCNT(j)]); sum += c; cnt += (c > 0u) ? 1u : 0u; mine = (j == x) ? c : mine; }
        if (sum == G) break;
        __builtin_amdgcn_s_sleep(1);
        if ((++sp & 255u) == 0u) { if (xb_ld(&bar[XB_TMO])) break; if (sp > XB_SPIN_CAP) { atomicAdd(&bar[XB_TMO], 1u); break; } }
    }
    nloc = mine > 0u ? mine : 1u; nx = cnt > 0u ? cnt : 1u;
}
__device__ __forceinline__ void xcd_barrier(const XcdBarrier& b) {
    asm volatile("s_waitcnt vmcnt(0)" ::: "memory");
    __syncthreads();
    if (threadIdx.x == 0) {
        unsigned* bar = b.bar;
        __builtin_amdgcn_s_waitcnt(0);
        unsigned nloc = b.st[0], nx = b.st[1];
        if (nloc == 0u) { xcd_barrier_complete(bar, b.x, nloc, nx); b.st[0] = nloc; b.st[1] = nx; }
        const unsigned old = xb_add(&bar[XB_XSUB(b.x)], 1u);
        const unsigned gen = old / nloc;
        if (old + 1u == (gen + 1u) * nloc) {
            __builtin_amdgcn_fence(__ATOMIC_RELEASE, "agent");
            asm volatile("s_waitcnt vmcnt(0)" ::: "memory");
            const unsigned og = xb_add(&bar[XB_TOP], 1u);
            const unsigned tg = og / nx;
            if (og + 1u == (tg + 1u) * nx) xb_add(&bar[XB_TOPGEN], 1u);
            else XB_SPIN(xb_ld(&bar[XB_TOPGEN]) == tg, bar);
            __builtin_amdgcn_fence(__ATOMIC_ACQUIRE, "agent");
            xb_add(&bar[XB_XGEN(b.x)], 1u);
            asm volatile("s_waitcnt vmcnt(0)" ::: "memory");
        } else {
            XB_SPIN(xb_ld(&bar[XB_XGEN(b.x)]) == gen, bar);
            __builtin_amdgcn_fence(__ATOMIC_ACQUIRE, "agent");
            asm volatile("s_waitcnt vmcnt(0)" ::: "memory");
        }
    }
    __syncthreads();
}

__global__ void __launch_bounds__(NTHREADS, 2) fwd_kernel(Args args) {
    extern __shared__ __attribute__((aligned(16))) unsigned char lds_raw[];
    LAS unsigned char* lds = (LAS unsigned char*)lds_raw;
    unsigned char* ws = args.ws;
    bf16_t* US = (bf16_t*)(ws + WS_US); bf16_t* XB = (bf16_t*)(ws + WS_US); float* R = (float*)(ws + WS_US);
    bf16_t* WIN = (bf16_t*)(ws + WS_WIN); bf16_t* WOUT = (bf16_t*)(ws + WS_WOUT); float* DEC = (float*)(ws + WS_DEC);
    bf16_t* H = (bf16_t*)(ws + WS_H); bf16_t* CAT = (bf16_t*)(ws + WS_CAT);
    const float* x = args.in[0]; const float* w_in = args.in[1]; const float* b_in = args.in[2]; const float* rpb = args.in[3];
    const float* lbf = args.in[4]; const float* lbb = args.in[5]; const float* hgain = args.in[6]; const float* w_out = args.in[7];
    const float* b_out = args.in[8]; const float* ln_g = args.in[9]; const float* ln_b = args.in[10];
    const int G = gridDim.x, bx = blockIdx.x;
    const int vcu = (G % 8 == 0) ? (bx % 8) * (G / 8) + bx / 8 : bx;
    const int lo = args.ph_lo, hi = args.ph_hi;
#define IN(k) (lo <= (k) && (k) < hi)
    volatile LAS unsigned* bst = (volatile LAS unsigned*)(lds + LDS_BYTES - 64);
    if (threadIdx.x == 0) { bst[0] = 0u; bst[1] = 0u; }
    __syncthreads();
    XcdBarrier bar; bar.bar = (unsigned*)(ws + WS_CTL); bar.x = 0; bar.st = bst;
    if (args.coop) bar = xcd_barrier_post((unsigned*)(ws + WS_CTL), bst);
#define SEAM(k) do { if (args.coop && IN(k) && IN((k) + 1)) xcd_barrier(bar); } while (0)
    if (IN(0)) p0_convert(x, w_in, w_out, XB, WIN, WOUT);
    SEAM(0);
    if (IN(1)) {
        pg8::Gemm gm{XB, WIN, MROWS, DIN, DM}; pg8::StaticOrder so; so.init(MROWS, DIN, G, vcu);
        EpiH ep{H, b_in};
        pg8::gemm_phase<EpiH, pg8::StaticOrder, true, true>(lds, gm, so, ep);
    }
    SEAM(1);
    if (IN(2)) {
        for (int at = bx; at < 1024; at += G) { const int a2 = (at % 256) * 4 + at / 256; attn_tile(lds, H, rpb, CAT, a2); }
        if (args.pad == 0) for (int ht = bx; ht < 1024; ht += G) hgrn_local_tile(lds, H, lbf, lbb, US, DEC, ht);
    }
    SEAM(2);
    if (IN(3)) hgrn_state_scan(US, DEC, args.pad);
    SEAM(3);
    if (IN(4)) { for (int ht = bx; ht < 1024; ht += G) hgrn_out_tile(lds, H, US, hgain, CAT, ht); }
    SEAM(4);
    if (IN(5)) {
        pg8::Gemm gm{CAT, WOUT, MROWS, DM, DM}; pg8::StaticOrder so; so.init(MROWS, DM, G, vcu);
        EpiR ep{R, b_out, x};
        pg8::gemm_phase<EpiR, pg8::StaticOrder, false, true>(lds, gm, so, ep);
    }
    SEAM(5);
    if (IN(6)) ln_rows(R, ln_g, ln_b, args.out);
#undef IN
#undef SEAM
}

extern "C" void kernel_launch(void* const* d_in, const int* in_sizes, int n_in, void* d_out, int out_size, void* d_ws, size_t ws_size, hipStream_t stream) {
    static int grid = 0;
    if (grid == 0) {
        int dev = 0, cus = 0, per_cu = 0;
        if (hipGetDevice(&dev) != hipSuccess || hipDeviceGetAttribute(&cus, hipDeviceAttributeMultiprocessorCount, dev) != hipSuccess) { fprintf(stderr, "kernel_launch: device query failed\n"); grid = -1; return; }
        if (hipFuncSetAttribute((const void*)fwd_kernel, hipFuncAttributeMaxDynamicSharedMemorySize, LDS_BYTES) != hipSuccess) { fprintf(stderr, "kernel_launch: hipFuncSetAttribute failed\n"); grid = -1; return; }
        if (hipOccupancyMaxActiveBlocksPerMultiprocessor(&per_cu, (const void*)fwd_kernel, NTHREADS, LDS_BYTES) != hipSuccess || per_cu < 1) { fprintf(stderr, "kernel_launch: occupancy query gave %d\n", per_cu); per_cu = 1; }
        (void)hipGetLastError();
        if (per_cu > 1) per_cu = 1;
        grid = cus * per_cu;
        if (ws_size < 256 * MiB) fprintf(stderr, "kernel_launch: workspace too small (%zu)\n", ws_size);
    }
    if (grid < 0) return;
    Args a{};
    for (int i = 0; i < 11; ++i) a.in[i] = (const float*)d_in[i];
    a.out = (float*)d_out; a.ws = (unsigned char*)d_ws;
#if MK_LAUNCHES == 1
    a.ph_lo = 0; a.ph_hi = 7; a.coop = 1;
    if (hipMemsetAsync((char*)d_ws + WS_CTL, 0, 16384, stream) != hipSuccess) { fprintf(stderr, "kernel_launch: memset failed\n"); return; }
    hipLaunchKernelGGL(fwd_kernel, dim3(grid), dim3(NTHREADS), LDS_BYTES, stream, a);
#else
    for (int p = 0; p < 7; ++p) {
        a.ph_lo = p; a.ph_hi = p + 1; a.coop = 0;
        int reps = 1;
#ifdef PROBE_PHASE
        if (p == PROBE_PHASE) reps = 1 + PROBE_N;
#endif
        for (int q = 0; q < reps; ++q) { a.pad = ((p == 2 || p == 3) && q + 1 < reps) ? 1 : 0; hipLaunchKernelGGL(fwd_kernel, dim3(grid), dim3(NTHREADS), LDS_BYTES, stream, a); }
    }
#endif
}
```

```cpp
#include <hip/hip_runtime.h>
#include <hip/hip_cooperative_groups.h>
#include <cstdio>
#include <cstdint>
namespace cg = cooperative_groups;
#define MK_LAUNCHES 1
#define OLD_P2B
namespace pg8 {
#define PG8_LAS __attribute__((address_space(3)))
typedef unsigned short bf16_t;
typedef short bf16x8 __attribute__((ext_vector_type(8)));
typedef float f32x4 __attribute__((ext_vector_type(4)));
typedef unsigned u32x4 __attribute__((ext_vector_type(4)));
constexpr int BM = 256, BK = 64, HALF = 128, HTB = HALF * BK * 2  , STAGE_BYTES = 8 * HTB, NXCD = 8, WGM = 8;

__host__ __device__ __forceinline__ int lds_byte(int r, int c) { const int st = (r >> 4) * 2 + (c >> 5), rr = r & 15, cc = c & 31, ob = rr * 64 + cc * 2; return st * 1024 + (ob ^ (((ob >> 9) & 1) << 5)); }
__host__ __device__ __forceinline__ void stage_rc(int b, int& R, int& C) { const int st = b / 1024, sb = b % 1024, swz = sb ^ (((sb >> 9) & 1) << 5); R = (st >> 1) * 16 + swz / 64; C = (st & 1) * 32 + (swz % 64) / 2; }
__host__ __device__ __forceinline__ int perm32(int rho) { const int n = rho >> 4, i = rho & 15; return 8 * (i >> 2) + 4 * n + (i & 3); }

struct Unit { int pm, pn; };
struct Gemm { const bf16_t* A; const bf16_t* Bt; int M, N, K; };

struct StaticOrder {
    int nM, nN, nwg, G, c;
    __host__ __device__ void init(int M, int N, int G_, int c_) { nM = M / BM; nN = N / BM; nwg = nM * nN; G = G_; c = c_; }
    __host__ __device__ bool next(int i, Unit& u) const {
        const long L = (long)i * G + c; if (L >= nwg) return false;
        int wgid = (int)L; { const int q = nwg / NXCD, r = nwg % NXCD, xcd = wgid % NXCD, off = wgid / NXCD; wgid = (xcd < r ? xcd * (q + 1) : r * (q + 1) + (xcd - r) * q) + off; }
        const int nig = WGM * nN, gid = wgid / nig, fm = gid * WGM, gsz = (nM - fm) < WGM ? (nM - fm) : WGM;
        u.pm = fm + ((wgid % nig) % gsz); u.pn = (wgid % nig) / gsz; return true;
    }
    __device__ __forceinline__ void a_ready(const Unit&) const {}
    __device__ __forceinline__ void done(const Unit&) const {}
};
__device__ __forceinline__ unsigned cvt_pk_bf16(float lo, float hi) { unsigned r; asm volatile("v_cvt_pk_bf16_f32 %0, %1, %2" : "=v"(r) : "v"(lo), "v"(hi)); return r; }
template <class Epi, class Sched, bool ALIGN_EPI = false, bool SP2 = false>
__device__ __forceinline__ void gemm_phase(PG8_LAS unsigned char* lds, const Gemm g, const Sched& S, const Epi& E) {
    const int tid = threadIdx.x, wid = __builtin_amdgcn_readfirstlane(tid >> 6), lane = tid & 63, wr = wid >> 2, wc = wid & 3, fr = lane & 15, fq = lane >> 4;
    const int K = g.K, nt = K / BK;
    unsigned voffA[2], voffB[2];
#pragma unroll
    for (int i = 0; i < 2; ++i) { int R, C; stage_rc(tid * 16 + i * 8192, R, C); const int Rb = Epi::PERM ? ((R & ~31) + perm32(R & 31)) : R;
        voffA[i] = (unsigned)(R * K + C) * 2u; voffB[i] = (unsigned)(Rb * K + C) * 2u; }
    const size_t kstep = (size_t)(BK * 2);
    const size_t hstep = (size_t)HALF * K * 2;
    const size_t tstep = 2 * hstep;
    const unsigned ldsw = (unsigned)wid * 1024u;
    const int aoff = lds_byte(wr * 64 + fr, fq * 8), boff = lds_byte(wc * 32 + fr, fq * 8);
#define PG8_SA(b, h) (((b) * 2 + (h)) * HTB)
#define PG8_SB(b, h) ((4 + (b) * 2 + (h)) * HTB)
#define PG8_STAGE(bufoff, gbase, voff) do { _Pragma("unroll") for (int _i = 0; _i < 2; ++_i) \
        __builtin_amdgcn_global_load_lds((const unsigned*)((const char*)(gbase) + (voff)[_i]), (PG8_LAS unsigned*)(lds + (bufoff) + ldsw + _i * 8192), 16, 0, 0); } while (0)
#define PG8_LDA(dst, b, h) do { _Pragma("unroll") for (int m = 0; m < 4; ++m) _Pragma("unroll") for (int k = 0; k < 2; ++k) dst[m][k] = *(const PG8_LAS bf16x8*)(lds + PG8_SA(b, h) + aoff + m * 2048 + k * 1024); } while (0)
#define PG8_LDB(dst, b, h) do { _Pragma("unroll") for (int n = 0; n < 2; ++n) _Pragma("unroll") for (int k = 0; k < 2; ++k) dst[n][k] = *(const PG8_LAS bf16x8*)(lds + PG8_SB(b, h) + boff + n * 2048 + k * 1024); } while (0)
#define PG8_MMA(ai, bj, At, Bt) do { __builtin_amdgcn_s_setprio(1); _Pragma("unroll") for (int m = 0; m < 4; ++m) _Pragma("unroll") for (int n = 0; n < 2; ++n) _Pragma("unroll") for (int k = 0; k < 2; ++k) \
        acc[ai][bj][m][n] = __builtin_amdgcn_mfma_f32_16x16x32_bf16(Bt[n][k], At[m][k], acc[ai][bj][m][n], 0, 0, 0); __builtin_amdgcn_s_setprio(0); } while (0)
#define PG8_WAIT_V(n) asm volatile("s_waitcnt vmcnt(" #n ")" ::: "memory")
#define PG8_WAIT_L(n) asm volatile("s_waitcnt lgkmcnt(" #n ")" ::: "memory")
#define PG8_BAR __builtin_amdgcn_s_barrier()
#define PG8_SCHED __builtin_amdgcn_sched_barrier(0)
    Unit cur, nxt; int ui = 0;
    if (!S.next(0, cur)) return;
    f32x4 acc[2][2][4][2];
#pragma unroll
    for (int a = 0; a < 2; ++a)
#pragma unroll
        for (int b = 0; b < 2; ++b)
#pragma unroll
            for (int m = 0; m < 4; ++m)
#pragma unroll
                for (int n = 0; n < 2; ++n) acc[a][b][m][n] = (f32x4){0.f, 0.f, 0.f, 0.f};
    bf16x8 At[4][2], B0[2][2], B1[2][2];
    const char* cA = (const char*)g.A + (size_t)cur.pm * tstep; const char* cB = (const char*)g.Bt + (size_t)cur.pn * tstep;
    S.a_ready(cur);
    if constexpr (SP2) {
        PG8_STAGE(PG8_SB(0, 0), cB, voffB); PG8_STAGE(PG8_SB(0, 1), cB + hstep, voffB); PG8_STAGE(PG8_SA(0, 0), cA, voffA); PG8_STAGE(PG8_SA(0, 1), cA + hstep, voffA);
        if (wr == 1) PG8_BAR;
        PG8_WAIT_V(2); PG8_BAR;
        PG8_STAGE(PG8_SB(1, 0), cB + kstep, voffB); PG8_STAGE(PG8_SA(1, 0), cA + kstep, voffA); PG8_STAGE(PG8_SB(1, 1), cB + hstep + kstep, voffB);
        PG8_WAIT_V(6); PG8_BAR;
    } else {
        PG8_STAGE(PG8_SB(0, 0), cB, voffB); PG8_STAGE(PG8_SA(0, 0), cA, voffA); PG8_STAGE(PG8_SB(0, 1), cB + hstep, voffB); PG8_STAGE(PG8_SA(0, 1), cA + hstep, voffA);
        if (wr == 1) PG8_BAR;
        PG8_WAIT_V(4); PG8_BAR;
        PG8_STAGE(PG8_SB(1, 0), cB + kstep, voffB); PG8_STAGE(PG8_SA(1, 0), cA + kstep, voffA); PG8_STAGE(PG8_SB(1, 1), cB + hstep + kstep, voffB);
        PG8_WAIT_V(6); PG8_BAR;
    }
    for (;;) {
        const bool has_next = S.next(ui + 1, nxt);
        const char* nA = has_next ? (const char*)g.A + (size_t)nxt.pm * tstep : cA; const char* nB = has_next ? (const char*)g.Bt + (size_t)nxt.pn * tstep : cB;
        for (int t = 0; t < nt; t += 2) {
            const bool last = (t == nt - 2);
            const char* a1 = cA + (size_t)(t + 1) * kstep;
            const char* a2 = last ? nA : cA + (size_t)(t + 2) * kstep; const char* b2 = last ? nB : cB + (size_t)(t + 2) * kstep;
            const char* a3 = a2 + kstep; const char* b3 = b2 + kstep;
            if (last && has_next) S.a_ready(nxt);
            if constexpr (SP2) {
            PG8_LDB(B0, 0, 0); PG8_LDB(B1, 0, 1); PG8_SCHED; PG8_LDA(At, 0, 0); PG8_STAGE(PG8_SA(1, 1), a1 + hstep, voffA);
            PG8_WAIT_V(8); PG8_WAIT_L(0); PG8_BAR; PG8_MMA(0, 0, At, B0); PG8_MMA(0, 1, At, B1); PG8_BAR; PG8_SCHED;
            PG8_LDA(At, 0, 1); PG8_STAGE(PG8_SB(0, 0), b2, voffB); PG8_STAGE(PG8_SB(0, 1), b2 + hstep, voffB); PG8_STAGE(PG8_SA(0, 0), a2, voffA);
            PG8_WAIT_V(8); PG8_WAIT_L(0); PG8_BAR; PG8_MMA(1, 0, At, B0); PG8_MMA(1, 1, At, B1); PG8_BAR; PG8_SCHED;
            PG8_LDB(B0, 1, 0); PG8_LDB(B1, 1, 1); PG8_SCHED; PG8_LDA(At, 1, 0); PG8_STAGE(PG8_SA(0, 1), a2 + hstep, voffA);
            PG8_WAIT_V(8); PG8_WAIT_L(0); PG8_BAR; PG8_MMA(0, 0, At, B0); PG8_MMA(0, 1, At, B1); PG8_BAR; PG8_SCHED;
            PG8_LDA(At, 1, 1); PG8_STAGE(PG8_SB(1, 0), b3, voffB); PG8_STAGE(PG8_SB(1, 1), b3 + hstep, voffB); PG8_STAGE(PG8_SA(1, 0), a3, voffA);
            PG8_WAIT_V(8); PG8_WAIT_L(0); PG8_BAR; PG8_MMA(1, 0, At, B0); PG8_MMA(1, 1, At, B1); PG8_BAR; PG8_SCHED;
            } else {
            PG8_LDB(B0, 0, 0); PG8_SCHED; PG8_LDA(At, 0, 0); PG8_STAGE(PG8_SA(1, 1), a1 + hstep, voffA);
            PG8_WAIT_L(8); PG8_BAR; PG8_WAIT_L(0); PG8_MMA(0, 0, At, B0); PG8_BAR; PG8_SCHED;
            PG8_LDB(B1, 0, 1); PG8_STAGE(PG8_SB(0, 0), b2, voffB);
            PG8_BAR; PG8_WAIT_L(0); PG8_MMA(0, 1, At, B1); PG8_BAR;
            PG8_LDA(At, 0, 1); PG8_STAGE(PG8_SA(0, 0), a2, voffA);
            PG8_BAR; PG8_WAIT_L(0); PG8_MMA(1, 0, At, B0); PG8_BAR; PG8_SCHED;
            PG8_STAGE(PG8_SB(0, 1), b2 + hstep, voffB);
            PG8_WAIT_V(6); PG8_BAR; PG8_MMA(1, 1, At, B1); PG8_BAR;
            PG8_LDB(B0, 1, 0); PG8_SCHED; PG8_LDA(At, 1, 0); PG8_STAGE(PG8_SA(0, 1), a2 + hstep, voffA);
            PG8_WAIT_L(8); PG8_BAR; PG8_WAIT_L(0); PG8_MMA(0, 0, At, B0); PG8_BAR; PG8_SCHED;
            PG8_LDB(B1, 1, 1); PG8_STAGE(PG8_SB(1, 0), b3, voffB);
            PG8_BAR; PG8_WAIT_L(0); PG8_MMA(0, 1, At, B1); PG8_BAR;
            PG8_LDA(At, 1, 1); PG8_STAGE(PG8_SA(1, 0), a3, voffA);
            PG8_BAR; PG8_WAIT_L(0); PG8_MMA(1, 0, At, B0); PG8_BAR; PG8_SCHED;
            PG8_STAGE(PG8_SB(1, 1), b3 + hstep, voffB);
            PG8_WAIT_V(6); PG8_BAR; PG8_MMA(1, 1, At, B1); PG8_BAR;
            }
        }
        if constexpr (ALIGN_EPI) { if (wr == 0) PG8_BAR; }
        if constexpr (!Epi::AFTER_DRAIN) { E(acc, cur, wr, wc, fr, fq); S.done(cur); }
        if (!has_next) break;
#pragma unroll
        for (int a = 0; a < 2; ++a)
#pragma unroll
            for (int b = 0; b < 2; ++b)
#pragma unroll
                for (int m = 0; m < 4; ++m)
#pragma unroll
                    for (int n = 0; n < 2; ++n) acc[a][b][m][n] = (f32x4){0.f, 0.f, 0.f, 0.f};
        cur = nxt; cA = nA; cB = nB; ++ui;
        if constexpr (ALIGN_EPI) { if (wr == 1) PG8_BAR; }
    }
    PG8_WAIT_V(0);
    if constexpr (!ALIGN_EPI) { if (wr == 0) PG8_BAR; }
    PG8_BAR;
    if constexpr (Epi::AFTER_DRAIN) { E.fused(acc, cur, wr, wc, fr, fq, lds, wid, lane); S.done(cur); }
#undef PG8_SA
#undef PG8_SB
#undef PG8_STAGE
#undef PG8_LDA
#undef PG8_LDB
#undef PG8_MMA
#undef PG8_WAIT_V
#undef PG8_WAIT_L
#undef PG8_BAR
#undef PG8_SCHED
}
}

#ifndef MK_LAUNCHES
#define MK_LAUNCHES 1
#endif
#define LAS __attribute__((address_space(3)))
typedef unsigned short bf16_t;
typedef short bf16x8 __attribute__((ext_vector_type(8)));
typedef float f32x4 __attribute__((ext_vector_type(4)));
typedef unsigned u32x4 __attribute__((ext_vector_type(4)));
typedef unsigned u32x2 __attribute__((ext_vector_type(2)));

constexpr int NTHREADS = 512;
constexpr int BATCH = 2, SEQ = 8192, DM = 1024, MROWS = BATCH * SEQ, DIN = 4608;
constexpr int C_QA = 0, C_KA = 512, C_VA = 1024, C_GA = 1536, C_QH = 2048, C_ZF = 2560, C_ZB = 3072, C_IH = 3584, C_GH = 4096;
constexpr float ALPHA = 1.189207115002721f;
constexpr size_t MiB = 1u << 20;
constexpr size_t WS_US = 0;
constexpr size_t WS_WIN = 64 * MiB, WS_WOUT = 73 * MiB, WS_DEC = 75 * MiB, WS_CTL = 77 * MiB;
constexpr size_t WS_H = 80 * MiB;
constexpr size_t WS_CAT = 224 * MiB;
constexpr int LDS_BYTES = 158720;

struct Args { const float* in[11]; float* out; unsigned char* ws; int ph_lo, ph_hi, coop, pad; };

__device__ __forceinline__ float bf2f(unsigned v) { return __builtin_bit_cast(float, v << 16); }
__device__ __forceinline__ unsigned f2bf(float f) { unsigned u = __builtin_bit_cast(unsigned, f); return (u + 0x7fffu + ((u >> 16) & 1u)) >> 16; }
__device__ __forceinline__ unsigned pk2(float lo, float hi) { return pg8::cvt_pk_bf16(lo, hi); }
__device__ __forceinline__ float sigmoidf_(float z) { return 1.f / (1.f + __expf(-z)); }
__device__ __forceinline__ float siluf_(float z) { return z / (1.f + __expf(-z)); }
__device__ __forceinline__ bf16x8 as_bf16x8(u32x4 v) { return __builtin_bit_cast(bf16x8, v); }

struct EpiH {
    static constexpr bool PERM = true, AFTER_DRAIN = false;
    bf16_t* O; const float* bias;
    __device__ __forceinline__ void operator()(const f32x4 (&acc)[2][2][4][2], const pg8::Unit& u, int wr, int wc, int fr, int fq) const {
        const int row0 = u.pm * 256 + wr * 64 + fr, col0 = u.pn * 256 + wc * 32 + 8 * fq;
        f32x4 bv[2][2];
#pragma unroll
        for (int bj = 0; bj < 2; ++bj)
#pragma unroll
            for (int n = 0; n < 2; ++n) bv[bj][n] = *(const f32x4*)(bias + col0 + bj * 128 + 4 * n);
#pragma unroll
        for (int ai = 0; ai < 2; ++ai)
#pragma unroll
            for (int m = 0; m < 4; ++m) { bf16_t* rowp = O + (size_t)(row0 + ai * 128 + m * 16) * DIN + col0;
#pragma unroll
                for (int bj = 0; bj < 2; ++bj) { f32x4 v0 = acc[ai][bj][m][0] + bv[bj][0], v1 = acc[ai][bj][m][1] + bv[bj][1];
                    u32x4 w; w.x = pk2(v0[0], v0[1]); w.y = pk2(v0[2], v0[3]); w.z = pk2(v1[0], v1[1]); w.w = pk2(v1[2], v1[3]);
                    *(u32x4*)(rowp + bj * 128) = w; } }
    }
};
struct EpiR {
    static constexpr bool PERM = false, AFTER_DRAIN = false;
    float* R; const float* bias; const float* x;
    __device__ __forceinline__ void operator()(const f32x4 (&acc)[2][2][4][2], const pg8::Unit& u, int wr, int wc, int fr, int fq) const {
        const int row0 = u.pm * 256 + wr * 64 + fr, col0 = u.pn * 256 + wc * 32 + 4 * fq;
        f32x4 bv[2][2];
#pragma unroll
        for (int bj = 0; bj < 2; ++bj)
#pragma unroll
            for (int n = 0; n < 2; ++n) bv[bj][n] = *(const f32x4*)(bias + col0 + bj * 128 + n * 16);
#pragma unroll
        for (int ai = 0; ai < 2; ++ai)
#pragma unroll
            for (int m = 0; m < 4; ++m) { const size_t ro = (size_t)(row0 + ai * 128 + m * 16) * DM + col0;
#pragma unroll
                for (int bj = 0; bj < 2; ++bj)
#pragma unroll
                    for (int n = 0; n < 2; ++n) { const f32x4 xv = *(const f32x4*)(x + ro + bj * 128 + n * 16);
                        *(f32x4*)(R + ro + bj * 128 + n * 16) = acc[ai][bj][m][n] + bv[bj][n] + xv * ALPHA; } }
    }
};

__device__ __forceinline__ void p0_convert(const float* x, const float* w_in, const float* w_out, bf16_t* XB, bf16_t* WIN, bf16_t* WOUT) {
    const int gt = blockIdx.x * NTHREADS + threadIdx.x, GT = gridDim.x * NTHREADS;
    for (int i = gt; i < MROWS * DM / 8; i += 4 * GT) {
        f32x4 a[4], b[4];
#pragma unroll
        for (int k = 0; k < 4; ++k) if (i + k * GT < MROWS * DM / 8) { const size_t o = (size_t)(i + k * GT) * 8; a[k] = __builtin_nontemporal_load((const f32x4*)(x + o)); b[k] = __builtin_nontemporal_load((const f32x4*)(x + o + 4)); }
#pragma unroll
        for (int k = 0; k < 4; ++k) if (i + k * GT < MROWS * DM / 8) { u32x4 w; w.x = pk2(a[k][0], a[k][1]); w.y = pk2(a[k][2], a[k][3]); w.z = pk2(b[k][0], b[k][1]); w.w = pk2(b[k][2], b[k][3]);
            *(u32x4*)(XB + (size_t)(i + k * GT) * 8) = w; }
    }
    for (int i = gt; i < DIN * 128; i += GT) {
        const int n = i % DIN, kb = i / DIN; float v[8];
#pragma unroll
        for (int j = 0; j < 8; ++j) v[j] = w_in[(size_t)(kb * 8 + j) * DIN + n];
        u32x4 w; w.x = pk2(v[0], v[1]); w.y = pk2(v[2], v[3]); w.z = pk2(v[4], v[5]); w.w = pk2(v[6], v[7]);
        *(u32x4*)(WIN + (size_t)n * 1024 + kb * 8) = w;
    }
    for (int i = gt; i < DM * 128; i += GT) {
        const int n = i % DM, kb = i / DM; float v[8];
#pragma unroll
        for (int j = 0; j < 8; ++j) v[j] = w_out[(size_t)(kb * 8 + j) * DM + n];
        u32x4 w; w.x = pk2(v[0], v[1]); w.y = pk2(v[2], v[3]); w.z = pk2(v[4], v[5]); w.w = pk2(v[6], v[7]);
        *(u32x4*)(WOUT + (size_t)n * 1024 + kb * 8) = w;
    }
}

constexpr int AT_VP = 520;
constexpr int AT_RPB_OFF = 2 * 64 * AT_VP * 2;
__device__ __forceinline__ void attn_tile(LAS unsigned char* lds, const bf16_t* H, const float* rpb, bf16_t* CAT, int at) {
    const int tid = threadIdx.x, lane = tid & 63, w = tid >> 6, fr = lane & 15, g = lane >> 4;
    const int b = at >> 9, hp = (at >> 7) & 3, r = at & 127;
    int rs = r - 4; rs = rs < 0 ? 0 : (rs > 120 ? 120 : rs);
    LAS bf16_t* VT = (LAS bf16_t*)lds;
    LAS float* RPB = (LAS float*)(lds + AT_RPB_OFF);
    {
        const size_t tok = (size_t)b * SEQ + (size_t)(rs + (tid >> 6)) * 64 + (tid & 63);
#pragma unroll
        for (int hh = 0; hh < 2; ++hh) {
            const bf16_t* src = H + tok * DIN + C_VA + (2 * hp + hh) * 64;
#pragma unroll
            for (int p = 0; p < 8; ++p) {
                const u32x4 v = *(const u32x4*)(src + 8 * p);
#pragma unroll
                for (int i = 0; i < 4; ++i) {
                    VT[(hh * 64 + 8 * p + 2 * i) * AT_VP + tid] = (bf16_t)(v[i] & 0xffffu);
                    VT[(hh * 64 + 8 * p + 2 * i + 1) * AT_VP + tid] = (bf16_t)(v[i] >> 16);
                }
            }
        }
        for (int i = tid; i < 930; i += NTHREADS) RPB[i] = rpb[hp * 930 + i];
    }
    __syncthreads();
    const int hh = w >> 2, j = w & 3, head = 2 * hp + hh;
    const int kc0 = (j == 0) ? 0 : (j == 1 ? 8 : (j == 2 ? 24 : 32));
    const size_t qtok = (size_t)b * SEQ + (size_t)r * 64 + 16 * j + fr;
    bf16x8 qf[2];
#pragma unroll
    for (int ks = 0; ks < 2; ++ks) qf[ks] = as_bf16x8(*(const u32x4*)(H + qtok * DIN + C_QA + head * 64 + ks * 32 + 8 * g));
    f32x4 S[16];
#pragma unroll
    for (int kt = 0; kt < 16; ++kt) {
        const int a = kt >> 1, ch = kt & 1;
        const size_t ktok = (size_t)b * SEQ + (size_t)(rs + a) * 64 + kc0 + 16 * ch + fr;
        const bf16_t* kp = H + ktok * DIN + C_KA + head * 64 + 8 * g;
        const bf16x8 k0 = as_bf16x8(*(const u32x4*)(kp)), k1 = as_bf16x8(*(const u32x4*)(kp + 32));
        f32x4 acc = {0.f, 0.f, 0.f, 0.f};
        acc = __builtin_amdgcn_mfma_f32_16x16x32_bf16(k0, qf[0], acc, 0, 0, 0);
        acc = __builtin_amdgcn_mfma_f32_16x16x32_bf16(k1, qf[1], acc, 0, 0, 0);
        S[kt] = acc;
    }
    const int qcol = 16 * j + fr;
    int cs = qcol - 8; cs = cs < 0 ? 0 : (cs > 48 ? 48 : cs);
    float mx = -1e30f;
#pragma unroll
    for (int kt = 0; kt < 16; ++kt) {
        const int a = kt >> 1, ch = kt & 1;
        const int dr = rs + a - r + 7;
#pragma unroll
        for (int rg = 0; rg < 4; ++rg) {
            const int kcol = kc0 + 16 * ch + 4 * g + rg;
            int dc = kcol - qcol + 15; dc = dc < 0 ? 0 : (dc > 30 ? 30 : dc);
            const bool inw = (unsigned)(kcol - cs) < 16u;
            const float s = S[kt][rg] * 0.125f + RPB[hh * 465 + dr * 31 + dc];
            S[kt][rg] = inw ? s : -1e30f;
            mx = fmaxf(mx, S[kt][rg]);
        }
    }
    mx = fmaxf(mx, __shfl_xor(mx, 16)); mx = fmaxf(mx, __shfl_xor(mx, 32));
    float sum = 0.f;
#pragma unroll
    for (int kt = 0; kt < 16; ++kt)
#pragma unroll
        for (int rg = 0; rg < 4; ++rg) { const float p = __expf(S[kt][rg] - mx); S[kt][rg] = p; sum += p; }
    sum += __shfl_xor(sum, 16); sum += __shfl_xor(sum, 32);
    f32x4 O[4];
#pragma unroll
    for (int mt = 0; mt < 4; ++mt) O[mt] = (f32x4){0.f, 0.f, 0.f, 0.f};
#pragma unroll
    for (int kk = 0; kk < 8; ++kk) {
        u32x4 pw; pw.x = pk2(S[2 * kk][0], S[2 * kk][1]); pw.y = pk2(S[2 * kk][2], S[2 * kk][3]);
        pw.z = pk2(S[2 * kk + 1][0], S[2 * kk + 1][1]); pw.w = pk2(S[2 * kk + 1][2], S[2 * kk + 1][3]);
        const bf16x8 pf = as_bf16x8(pw);
        const int key1 = kk * 64 + kc0 + 4 * g;
#pragma unroll
        for (int mt = 0; mt < 4; ++mt) {
            const LAS bf16_t* vp = VT + (hh * 64 + 16 * mt + fr) * AT_VP + key1;
            const u32x2 lo = *(const LAS u32x2*)(vp), hi = *(const LAS u32x2*)(vp + 16);
            u32x4 vw; vw.x = lo.x; vw.y = lo.y; vw.z = hi.x; vw.w = hi.y;
            O[mt] = __builtin_amdgcn_mfma_f32_16x16x32_bf16(as_bf16x8(vw), pf, O[mt], 0, 0, 0);
        }
    }
    const float inv = 1.f / sum;
#pragma unroll
    for (int mt = 0; mt < 4; ++mt) {
        const int e = 16 * mt + 4 * g;
        const u32x2 gw = *(const u32x2*)(H + qtok * DIN + C_GA + head * 64 + e);
        const float g0 = bf2f(gw.x & 0xffffu), g1 = bf2f(gw.x >> 16), g2 = bf2f(gw.y & 0xffffu), g3 = bf2f(gw.y >> 16);
        u32x2 ow; ow.x = pk2(O[mt][0] * inv * siluf_(g0), O[mt][1] * inv * siluf_(g1)); ow.y = pk2(O[mt][2] * inv * siluf_(g2), O[mt][3] * inv * siluf_(g3));
        *(u32x2*)(CAT + qtok * DM + head * 64 + e) = ow;
    }
    __syncthreads();
}

#ifdef OLD_P2B
constexpr int OHG_QS = 0, OHG_VT = 16384, OHG_LF = 34816, OHG_ZS = 67584, OHG_QT = 83968, OHG_KP = 101376, OHG_KPT = 118784, OHG_TOT = 137216, OHG_DECS = 139264;
constexpr int OHG_VP = 72, OHG_QP = 136;
__device__ __forceinline__ void hgrn_local_tile(LAS unsigned char* lds, bf16_t* H, const float* lbf, const float* lbb, bf16_t* US, float* DEC, int ht) {
    const int tid = threadIdx.x, lane = tid & 63, w = tid >> 6, fr = lane & 15, g = lane >> 4;
    const int b = ht >> 9, h = (ht >> 7) & 3, c = ht & 127;
    const size_t tok0 = (size_t)b * SEQ + (size_t)c * 64;
    LAS bf16_t* QS = (LAS bf16_t*)(lds + OHG_QS); LAS bf16_t* VT = (LAS bf16_t*)(lds + OHG_VT); LAS float* LF = (LAS float*)(lds + OHG_LF);
    LAS bf16_t* ZS = (LAS bf16_t*)(lds + OHG_ZS); LAS bf16_t* QT = (LAS bf16_t*)(lds + OHG_QT); LAS bf16_t* KP = (LAS bf16_t*)(lds + OHG_KP);
    LAS bf16_t* KPT = (LAS bf16_t*)(lds + OHG_KPT); LAS float* TOT = (LAS float*)(lds + OHG_TOT); LAS float* DECS = (LAS float*)(lds + OHG_DECS);
#pragma unroll
    for (int i = 0; i < 2; ++i) {
        const int p = tid + i * NTHREADS, s = p >> 4, d8 = (p & 15) * 8;
        const bf16_t* rowp = H + (tok0 + s) * DIN + h * 128 + d8;
        *(LAS u32x4*)(QS + s * 128 + d8) = *(const u32x4*)(rowp + C_QH);
        const u32x4 v = *(const u32x4*)(rowp + C_IH);
#pragma unroll
        for (int k = 0; k < 4; ++k) { VT[(d8 + 2 * k) * OHG_VP + s] = (bf16_t)(v[k] & 0xffffu); VT[(d8 + 2 * k + 1) * OHG_VP + s] = (bf16_t)(v[k] >> 16); }
    }
    const int d = tid & 127, sq = tid >> 7;
    const int tt = w & 3, eh = w >> 2;
    f32x4 OI[4];
#pragma unroll
    for (int nt = 0; nt < 4; ++nt) OI[nt] = (f32x4){0.f, 0.f, 0.f, 0.f};
    for (int dir = 0; dir < 2; ++dir) {
        const float* lbl = dir ? lbb : lbf;
        const float lb = 1.f / (1.f + __expf(lbl[512 + h * 128 + d] - lbl[h * 128 + d]));
        const int zc = dir ? C_ZB : C_ZF;
#pragma unroll
        for (int i = 0; i < 2; ++i) {
            const int p = tid + i * NTHREADS, s = p >> 4, d8 = (p & 15) * 8;
            *(LAS u32x4*)(ZS + s * 128 + d8) = *(const u32x4*)(H + (tok0 + s) * DIN + zc + h * 128 + d8);
        }
        __syncthreads();
        float kreg[16];
#pragma unroll
        for (int i = 0; i < 16; ++i) {
            const int s = sq + 4 * i;
            const float z = bf2f(ZS[s * 128 + d]);
            const float ez = __expf(-z), sg = 1.f / (1.f + ez);
            const float f = lb + (1.f - lb) * sg;
            LF[s * 128 + d] = __logf(f);
            kreg[i] = (1.f - lb) * (1.f - sg);
        }
        __syncthreads();
        {
            float run = 0.f;
#pragma unroll
            for (int i = 0; i < 16; ++i) {
                const int s = dir ? (16 * sq + 15 - i) : (16 * sq + i);
                run += LF[s * 128 + d]; LF[s * 128 + d] = run;
            }
            TOT[sq * 128 + d] = run;
        }
        __syncthreads();
        {
            const float t0 = TOT[d], t1 = TOT[128 + d], t2 = TOT[256 + d], t3 = TOT[384 + d];
            float pre[4];
            if (dir == 0) { pre[0] = 0.f; pre[1] = t0; pre[2] = t0 + t1; pre[3] = t0 + t1 + t2; }
            else          { pre[3] = 0.f; pre[2] = t3; pre[1] = t3 + t2; pre[0] = t3 + t2 + t1; }
            if (tid < 128) { const float dec = __expf(t0 + t1 + t2 + t3); DECS[d] = dec; DEC[((size_t)((dir * 8 + b * 4 + h) * 128 + c)) * 128 + d] = dec; }
#pragma unroll
            for (int i = 0; i < 16; ++i) {
                const int s = sq + 4 * i;
                const float bb = LF[s * 128 + d] + pre[i >> 2];
                const float eq = __expf(bb), ek = __expf(-bb);
                const float qv = bf2f(QS[s * 128 + d]);
                const bf16_t qt = (bf16_t)f2bf(qv * eq), kp = (bf16_t)f2bf(kreg[i] * ek);
                QT[s * OHG_QP + d] = qt; KP[s * OHG_QP + d] = kp; KPT[d * OHG_VP + s] = kp;
            }
        }
        __syncthreads();
        {
            f32x4 aT[4];
#pragma unroll
            for (int st = 0; st < 4; ++st) {
                f32x4 acc = {0.f, 0.f, 0.f, 0.f};
                const bool live = dir ? (st >= tt) : (st <= tt);
                if (live) {
#pragma unroll
                    for (int ks = 0; ks < 4; ++ks) {
                        const bf16x8 af = *(const LAS bf16x8*)(KP + (16 * st + fr) * OHG_QP + 32 * ks + 8 * g);
                        const bf16x8 bfr = *(const LAS bf16x8*)(QT + (16 * tt + fr) * OHG_QP + 32 * ks + 8 * g);
                        acc = __builtin_amdgcn_mfma_f32_16x16x32_bf16(af, bfr, acc, 0, 0, 0);
                    }
                    const int t = 16 * tt + fr;
#pragma unroll
                    for (int rg = 0; rg < 4; ++rg) { const int s = 16 * st + 4 * g + rg; const bool keep = dir ? (s >= t) : (s <= t); acc[rg] = keep ? acc[rg] : 0.f; }
                }
                aT[st] = acc;
            }
#pragma unroll
            for (int kk = 0; kk < 2; ++kk) {
                u32x4 aw; aw.x = pk2(aT[2 * kk][0], aT[2 * kk][1]); aw.y = pk2(aT[2 * kk][2], aT[2 * kk][3]);
                aw.z = pk2(aT[2 * kk + 1][0], aT[2 * kk + 1][1]); aw.w = pk2(aT[2 * kk + 1][2], aT[2 * kk + 1][3]);
                const bf16x8 af = as_bf16x8(aw);
#pragma unroll
                for (int nt = 0; nt < 4; ++nt) {
                    const LAS bf16_t* vp = VT + (64 * eh + 16 * nt + fr) * OHG_VP + 32 * kk + 4 * g;
                    const u32x2 lo = *(const LAS u32x2*)(vp), hi = *(const LAS u32x2*)(vp + 16);
                    u32x4 vw; vw.x = lo.x; vw.y = lo.y; vw.z = hi.x; vw.w = hi.y;
                    OI[nt] = __builtin_amdgcn_mfma_f32_16x16x32_bf16(af, as_bf16x8(vw), OI[nt], 0, 0, 0);
                }
            }
        }
        {
            const bf16x8 va0 = *(const LAS bf16x8*)(VT + (16 * w + fr) * OHG_VP + 8 * g), va1 = *(const LAS bf16x8*)(VT + (16 * w + fr) * OHG_VP + 32 + 8 * g);
            bf16_t* up = US + ((size_t)((dir * 8 + b * 4 + h) * 128 + c)) * 16384;
#pragma unroll
            for (int dt = 0; dt < 8; ++dt) {
                const bf16x8 kb0 = *(const LAS bf16x8*)(KPT + (16 * dt + fr) * OHG_VP + 8 * g), kb1 = *(const LAS bf16x8*)(KPT + (16 * dt + fr) * OHG_VP + 32 + 8 * g);
                f32x4 acc = {0.f, 0.f, 0.f, 0.f};
                acc = __builtin_amdgcn_mfma_f32_16x16x32_bf16(va0, kb0, acc, 0, 0, 0);
                acc = __builtin_amdgcn_mfma_f32_16x16x32_bf16(va1, kb1, acc, 0, 0, 0);
                const float dec = DECS[16 * dt + fr];
#pragma unroll
                for (int rg = 0; rg < 4; ++rg) up[(16 * w + 4 * g + rg) * 128 + 16 * dt + fr] = (bf16_t)f2bf(acc[rg] * dec);
            }
        }
#pragma unroll
        for (int i = 0; i < 2; ++i) {
            const int p = tid + i * NTHREADS, s = p >> 4, d8 = (p & 15) * 8;
            *(u32x4*)(H + (tok0 + s) * DIN + zc + h * 128 + d8) = *(const LAS u32x4*)(QT + s * OHG_QP + d8);
        }
        __syncthreads();
    }
#pragma unroll
    for (int nt = 0; nt < 4; ++nt)
#pragma unroll
        for (int rg = 0; rg < 4; ++rg)
            H[(tok0 + 16 * tt + 4 * g + rg) * DIN + C_QH + h * 128 + 64 * eh + 16 * nt + fr] = (bf16_t)f2bf(OI[nt][rg]);
}

#endif
constexpr int HG_QS = 0, HG_VT = 16384, HG_ZQ = 34816, HG_KP = 69632, HG_KPT = 104448, HG_TOT = 141312, HG_DECS = 143360;
constexpr int HG_VP = 72, HG_QP = 136;
constexpr int HG_DIRQ = 64 * HG_QP, HG_DIRT = 128 * HG_VP;
struct HgPre { u32x4 q[2], v[2], zf[2], zb[2]; };
__device__ __forceinline__ void hg_prefetch(HgPre& P, const bf16_t* H, int ht) {
    const int tid = threadIdx.x, b = ht >> 9, h = (ht >> 7) & 3, c = ht & 127;
    const size_t tok0 = (size_t)b * SEQ + (size_t)c * 64;
#pragma unroll
    for (int i = 0; i < 2; ++i) {
        const int p = tid + i * NTHREADS, s = p >> 4, d8 = (p & 15) * 8;
        const bf16_t* rowp = H + (tok0 + s) * DIN + h * 128 + d8;
        P.q[i] = *(const u32x4*)(rowp + C_QH); P.v[i] = *(const u32x4*)(rowp + C_IH); P.zf[i] = *(const u32x4*)(rowp + C_ZF); P.zb[i] = *(const u32x4*)(rowp + C_ZB);
    }
}
template <int DIRV> __device__ __forceinline__ void hg_s1(const LAS bf16_t* ZQd, LAS float* TOTd, float lb, int hf, int d, float (&cum)[32], float (&kk_)[32]) {
    const LAS bf16_t* zp = ZQd + (32 * hf) * HG_QP + d;
    float run = 0.f;
#pragma unroll
    for (int i = 0; i < 32; ++i) {
        const float z = bf2f(zp[(DIRV ? (31 - i) : i) * HG_QP]);
        const float ez = __expf(-z), sg = __builtin_amdgcn_rcpf(1.f + ez);
        const float f = lb + (1.f - lb) * sg;
        run += __logf(f); cum[i] = run; kk_[i] = (1.f - lb) * (1.f - sg);
    }
    TOTd[hf * 128 + d] = run;
}
template <int DIRV> __device__ __forceinline__ void hg_s2(const LAS bf16_t* QS, LAS bf16_t* ZQd, LAS bf16_t* KPd, LAS bf16_t* KPTd, float pre, int hf, int d, const float (&cum)[32], const float (&kk_)[32]) {
    const LAS bf16_t* qp = QS + (32 * hf) * 128 + d;
    LAS bf16_t* zq = ZQd + (32 * hf) * HG_QP + d; LAS bf16_t* kp = KPd + (32 * hf) * HG_QP + d; LAS bf16_t* kt = KPTd + d * HG_VP + 32 * hf;
#pragma unroll
    for (int i = 0; i < 32; i += 2) {
        const int sA = DIRV ? (31 - i) : i, sB = DIRV ? (sA - 1) : (sA + 1);
        const float bA = cum[i] + pre, bB = cum[i + 1] + pre;
        const float qA = bf2f(qp[sA * 128]), qB = bf2f(qp[sB * 128]);
        const unsigned qtA = f2bf(qA * __expf(bA)), qtB = f2bf(qB * __expf(bB));
        const unsigned kpA = f2bf(kk_[i] * __expf(-bA)), kpB = f2bf(kk_[i + 1] * __expf(-bB));
        zq[sA * HG_QP] = (bf16_t)qtA; zq[sB * HG_QP] = (bf16_t)qtB;
        kp[sA * HG_QP] = (bf16_t)kpA; kp[sB * HG_QP] = (bf16_t)kpB;
        *(LAS unsigned*)(kt + (DIRV ? sB : sA)) = DIRV ? (kpB | (kpA << 16)) : (kpA | (kpB << 16));
    }
}
__device__ __forceinline__ void hgrn_local_phase(LAS unsigned char* lds, bf16_t* H, const float* lbf, const float* lbb, bf16_t* US, float* DEC, int bx, int G) {
    const int tid = threadIdx.x, lane = tid & 63, w = tid >> 6, fr = lane & 15, g = lane >> 4;
    LAS bf16_t* QS = (LAS bf16_t*)(lds + HG_QS); LAS bf16_t* VT = (LAS bf16_t*)(lds + HG_VT); LAS bf16_t* ZQ = (LAS bf16_t*)(lds + HG_ZQ);
    LAS bf16_t* KP = (LAS bf16_t*)(lds + HG_KP); LAS bf16_t* KPT = (LAS bf16_t*)(lds + HG_KPT); LAS float* TOT = (LAS float*)(lds + HG_TOT); LAS float* DECS = (LAS float*)(lds + HG_DECS);
    if (bx >= 1024) return;
    HgPre P; hg_prefetch(P, H, bx);
    const int d = tid & 127, hf = (tid >> 7) & 1, edir = tid >> 8;
    for (int ht = bx; ht < 1024; ht += G) {
        const int b = ht >> 9, h = (ht >> 7) & 3, c = ht & 127;
        const size_t tok0 = (size_t)b * SEQ + (size_t)c * 64;
#ifdef HG_NOPF
        if (ht != bx) hg_prefetch(P, H, ht);
#endif
#pragma unroll
        for (int i = 0; i < 2; ++i) {
            const int p = tid + i * NTHREADS, s = p >> 4, d8 = (p & 15) * 8;
            *(LAS u32x4*)(QS + s * 128 + d8) = P.q[i];
            *(LAS u32x4*)(ZQ + s * HG_QP + d8) = P.zf[i];
            *(LAS u32x4*)(ZQ + HG_DIRQ + s * HG_QP + d8) = P.zb[i];
#pragma unroll
            for (int k = 0; k < 4; ++k) { VT[(d8 + 2 * k) * HG_VP + s] = (bf16_t)(P.v[i][k] & 0xffffu); VT[(d8 + 2 * k + 1) * HG_VP + s] = (bf16_t)(P.v[i][k] >> 16); }
        }
        __syncthreads();
#ifndef HG_NOPF
        if (ht + G < 1024) hg_prefetch(P, H, ht + G);
#endif
        const float* lbl = edir ? lbb : lbf;
        const float lb = 1.f / (1.f + __expf(lbl[512 + h * 128 + d] - lbl[h * 128 + d]));
        float cum[32], kk_[32];
        if (edir == 0) hg_s1<0>(ZQ, TOT, lb, hf, d, cum, kk_); else hg_s1<1>(ZQ + HG_DIRQ, TOT + 256, lb, hf, d, cum, kk_);
        __syncthreads();
        {
            const float t0 = TOT[(edir * 2) * 128 + d], t1 = TOT[(edir * 2 + 1) * 128 + d];
            const float pre = edir ? (hf ? 0.f : t1) : (hf ? t0 : 0.f);
            if (hf == 0) { const float dec = __expf(t0 + t1); DECS[edir * 128 + d] = dec; DEC[((size_t)((edir * 8 + b * 4 + h) * 128 + c)) * 128 + d] = dec; }
            if (edir == 0) hg_s2<0>(QS, ZQ, KP, KPT, pre, hf, d, cum, kk_); else hg_s2<1>(QS, ZQ + HG_DIRQ, KP + HG_DIRQ, KPT + HG_DIRT, pre, hf, d, cum, kk_);
        }
        __syncthreads();
        {
            const int tt = w & 3, eh = w >> 2;
            f32x4 OI[4];
#pragma unroll
            for (int et = 0; et < 4; ++et) OI[et] = (f32x4){0.f, 0.f, 0.f, 0.f};
#pragma unroll
            for (int dir = 0; dir < 2; ++dir) {
                f32x4 aT[4];
#pragma unroll
                for (int st = 0; st < 4; ++st) {
                    f32x4 acc = {0.f, 0.f, 0.f, 0.f};
                    const bool live = dir ? (st >= tt) : (st <= tt);
                    if (live) {
#pragma unroll
                        for (int ks = 0; ks < 4; ++ks) {
                            const bf16x8 af = *(const LAS bf16x8*)(KP + dir * HG_DIRQ + (16 * st + fr) * HG_QP + 32 * ks + 8 * g);
                            const bf16x8 bfr = *(const LAS bf16x8*)(ZQ + dir * HG_DIRQ + (16 * tt + fr) * HG_QP + 32 * ks + 8 * g);
                            acc = __builtin_amdgcn_mfma_f32_16x16x32_bf16(af, bfr, acc, 0, 0, 0);
                        }
                        const int t = 16 * tt + fr;
#pragma unroll
                        for (int rg = 0; rg < 4; ++rg) { const int s = 16 * st + 4 * g + rg; const bool keep = dir ? (s >= t) : (s <= t); acc[rg] = keep ? acc[rg] : 0.f; }
                    }
                    aT[st] = acc;
                }
#pragma unroll
                for (int kk = 0; kk < 2; ++kk) {
                    u32x4 aw; aw.x = pk2(aT[2 * kk][0], aT[2 * kk][1]); aw.y = pk2(aT[2 * kk][2], aT[2 * kk][3]);
                    aw.z = pk2(aT[2 * kk + 1][0], aT[2 * kk + 1][1]); aw.w = pk2(aT[2 * kk + 1][2], aT[2 * kk + 1][3]);
                    const bf16x8 pb = as_bf16x8(aw);
#pragma unroll
                    for (int et = 0; et < 4; ++et) {
                        const LAS bf16_t* vp = VT + (64 * eh + 16 * et + fr) * HG_VP + 32 * kk + 4 * g;
                        const u32x2 lo = *(const LAS u32x2*)(vp), hi = *(const LAS u32x2*)(vp + 16);
                        u32x4 vw; vw.x = lo.x; vw.y = lo.y; vw.z = hi.x; vw.w = hi.y;
                        OI[et] = __builtin_amdgcn_mfma_f32_16x16x32_bf16(as_bf16x8(vw), pb, OI[et], 0, 0, 0);
                    }
                }
            }
#pragma unroll
            for (int et = 0; et < 4; ++et) {
                u32x2 ow; ow.x = pk2(OI[et][0], OI[et][1]); ow.y = pk2(OI[et][2], OI[et][3]);
                *(u32x2*)(H + (tok0 + 16 * tt + fr) * DIN + C_QH + h * 128 + 64 * eh + 16 * et + 4 * g) = ow;
            }
        }
        {
            const int dir = w >> 2, ep = w & 3;
            bf16x8 vb[2][2];
#pragma unroll
            for (int j = 0; j < 2; ++j)
#pragma unroll
                for (int ks = 0; ks < 2; ++ks) vb[j][ks] = *(const LAS bf16x8*)(VT + (32 * ep + 16 * j + fr) * HG_VP + 32 * ks + 8 * g);
            bf16_t* up = US + ((size_t)((dir * 8 + b * 4 + h) * 128 + c)) * 16384;
#pragma unroll
            for (int dt = 0; dt < 8; ++dt) {
                const bf16x8 ka0 = *(const LAS bf16x8*)(KPT + dir * HG_DIRT + (16 * dt + fr) * HG_VP + 8 * g), ka1 = *(const LAS bf16x8*)(KPT + dir * HG_DIRT + (16 * dt + fr) * HG_VP + 32 + 8 * g);
                const f32x4 dec = *(const LAS f32x4*)(DECS + dir * 128 + 16 * dt + 4 * g);
#pragma unroll
                for (int j = 0; j < 2; ++j) {
                    f32x4 acc = {0.f, 0.f, 0.f, 0.f};
                    acc = __builtin_amdgcn_mfma_f32_16x16x32_bf16(ka0, vb[j][0], acc, 0, 0, 0);
                    acc = __builtin_amdgcn_mfma_f32_16x16x32_bf16(ka1, vb[j][1], acc, 0, 0, 0);
                    acc = acc * dec;
                    u32x2 ow; ow.x = pk2(acc[0], acc[1]); ow.y = pk2(acc[2], acc[3]);
                    *(u32x2*)(up + (32 * ep + 16 * j + fr) * 128 + 16 * dt + 4 * g) = ow;
                }
            }
        }
#pragma unroll
        for (int i = 0; i < 4; ++i) {
            const int p = tid + i * NTHREADS, dir = p >> 10, pp = p & 1023, s = pp >> 4, d8 = (pp & 15) * 8;
            *(u32x4*)(H + (tok0 + s) * DIN + (dir ? C_ZB : C_ZF) + h * 128 + d8) = *(const LAS u32x4*)(ZQ + dir * HG_DIRQ + s * HG_QP + d8);
        }
        __syncthreads();
    }
}

__device__ __forceinline__ void hgrn_state_scan(bf16_t* US, const float* DEC, int dry) {
    if (threadIdx.x >= 256) return;
    const int gt = blockIdx.x * 256 + threadIdx.x, GT = gridDim.x * 256;
    for (int it = gt; it < 16 * 4096; it += GT) {
        const int sidx = it >> 12, rem = (it & 4095) * 4, d = rem & 127, dir = sidx >> 3;
        f32x4 st = {0.f, 0.f, 0.f, 0.f};
        for (int c0 = 0; c0 < 128; c0 += 8) {
            u32x2 u[8]; f32x4 dc[8];
#pragma unroll
            for (int k = 0; k < 8; ++k) {
                const int c = dir ? (127 - c0 - k) : (c0 + k);
                u[k] = *(const u32x2*)(US + ((size_t)(sidx * 128 + c)) * 16384 + rem);
                dc[k] = *(const f32x4*)(DEC + ((size_t)(sidx * 128 + c)) * 128 + d);
            }
#pragma unroll
            for (int k = 0; k < 8; ++k) {
                const int c = dir ? (127 - c0 - k) : (c0 + k);
                u32x2 o; o.x = pk2(st[0], st[1]); o.y = pk2(st[2], st[3]);
                *(u32x2*)(US + ((size_t)(sidx * 128 + c)) * 16384 + rem) = dry ? u[k] : o;
                const f32x4 uv = {bf2f(u[k].x & 0xffffu), bf2f(u[k].x >> 16), bf2f(u[k].y & 0xffffu), bf2f(u[k].y >> 16)};
                st = dc[k] * st + uv;
            }
        }
    }
}

__device__ __forceinline__ void hgrn_out_phase(const bf16_t* H, const bf16_t* US, const float* gain, bf16_t* CAT, int bx, int G) {
    const int tid = threadIdx.x, lane = tid & 63, w = tid >> 6, fr = lane & 15, g = lane >> 4;
    for (int item = bx * 8 + w; item < 2048; item += G * 8) {
        const int ht = item >> 1, tp = item & 1;
        const int b = ht >> 9, h = (ht >> 7) & 3, c = ht & 127;
        const size_t tok0 = (size_t)b * SEQ + (size_t)c * 64 + 32 * tp;
        f32x4 acc[2][8];
#pragma unroll
        for (int j = 0; j < 2; ++j)
#pragma unroll
            for (int et = 0; et < 8; ++et) acc[j][et] = (f32x4){0.f, 0.f, 0.f, 0.f};
        {
            const bf16_t* sp0 = US + ((size_t)((0 * 8 + b * 4 + h) * 128 + c)) * 16384 + 8 * g + fr * 128;
            const bf16_t* sp1 = US + ((size_t)((1 * 8 + b * 4 + h) * 128 + c)) * 16384 + 8 * g + fr * 128;
            const bf16_t* qp = H + (tok0 + fr) * DIN + h * 128 + 8 * g;
            bf16x8 qb[2][4], cur[8], nxt[8];
#pragma unroll
            for (int j = 0; j < 2; ++j)
#pragma unroll
                for (int ks = 0; ks < 4; ++ks) qb[j][ks] = as_bf16x8(*(const u32x4*)(qp + (size_t)(16 * j) * DIN + C_ZF + 32 * ks));
#pragma unroll
            for (int i = 0; i < 8; ++i) cur[i] = as_bf16x8(*(const u32x4*)(sp0 + (16 * (i >> 2)) * 128 + 32 * (i & 3)));
#pragma unroll
            for (int p = 0; p < 8; ++p) {
                const int et2 = p & 3;
                if (p + 1 < 8) { const bf16_t* spn = ((p + 1) >> 2) ? sp1 : sp0; const int e2n = (p + 1) & 3;
#pragma unroll
                    for (int i = 0; i < 8; ++i) nxt[i] = as_bf16x8(*(const u32x4*)(spn + (16 * (2 * e2n + (i >> 2))) * 128 + 32 * (i & 3))); }
#pragma unroll
                for (int e = 0; e < 2; ++e)
#pragma unroll
                    for (int ks = 0; ks < 4; ++ks) {
                        acc[0][2 * et2 + e] = __builtin_amdgcn_mfma_f32_16x16x32_bf16(cur[e * 4 + ks], qb[0][ks], acc[0][2 * et2 + e], 0, 0, 0);
                        acc[1][2 * et2 + e] = __builtin_amdgcn_mfma_f32_16x16x32_bf16(cur[e * 4 + ks], qb[1][ks], acc[1][2 * et2 + e], 0, 0, 0);
                    }
                if (p == 3) {
#pragma unroll
                    for (int j = 0; j < 2; ++j)
#pragma unroll
                        for (int ks = 0; ks < 4; ++ks) qb[j][ks] = as_bf16x8(*(const u32x4*)(qp + (size_t)(16 * j) * DIN + C_ZB + 32 * ks));
                }
                __builtin_amdgcn_sched_barrier(0);
#pragma unroll
                for (int i = 0; i < 8; ++i) cur[i] = nxt[i];
            }
        }
#pragma unroll
        for (int j = 0; j < 2; ++j) {
            const bf16_t* hrow = H + (tok0 + 16 * j + fr) * DIN + h * 128 + 4 * g;
            float ssq = 0.f;
#pragma unroll
            for (int et = 0; et < 8; ++et) {
                const u32x2 oi = *(const u32x2*)(hrow + C_QH + 16 * et);
                acc[j][et][0] += bf2f(oi.x & 0xffffu); acc[j][et][1] += bf2f(oi.x >> 16); acc[j][et][2] += bf2f(oi.y & 0xffffu); acc[j][et][3] += bf2f(oi.y >> 16);
                ssq += acc[j][et][0] * acc[j][et][0] + acc[j][et][1] * acc[j][et][1] + acc[j][et][2] * acc[j][et][2] + acc[j][et][3] * acc[j][et][3];
            }
            ssq += __shfl_xor(ssq, 16); ssq += __shfl_xor(ssq, 32);
            const float rsn = rsqrtf(ssq * (1.f / 128.f) + 1e-6f);
#pragma unroll
            for (int et = 0; et < 8; ++et) {
                const u32x2 gw = *(const u32x2*)(hrow + C_GH + 16 * et);
                const f32x4 gn = *(const f32x4*)(gain + h * 128 + 16 * et + 4 * g);
                const float g0 = bf2f(gw.x & 0xffffu), g1 = bf2f(gw.x >> 16), g2 = bf2f(gw.y & 0xffffu), g3 = bf2f(gw.y >> 16);
                u32x2 ow; ow.x = pk2(acc[j][et][0] * rsn * gn[0] * siluf_(g0), acc[j][et][1] * rsn * gn[1] * siluf_(g1));
                ow.y = pk2(acc[j][et][2] * rsn * gn[2] * siluf_(g2), acc[j][et][3] * rsn * gn[3] * siluf_(g3));
                *(u32x2*)(CAT + (tok0 + 16 * j + fr) * DM + 512 + h * 128 + 16 * et + 4 * g) = ow;
            }
        }
    }
}

#ifdef OLD_P4
__device__ __forceinline__ void hgrn_out_tile(LAS unsigned char* lds, const bf16_t* H, const bf16_t* US, const float* gain, bf16_t* CAT, int ht) {
    const int tid = threadIdx.x, lane = tid & 63, w = tid >> 6, fr = lane & 15, g = lane >> 4;
    const int b = ht >> 9, h = (ht >> 7) & 3, c = ht & 127;
    const size_t tok0 = (size_t)b * SEQ + (size_t)c * 64;
    const int tt = w & 3, eh = w >> 2;
    LAS float* SSQ = (LAS float*)lds;
    f32x4 acc[4];
#pragma unroll
    for (int nt = 0; nt < 4; ++nt) acc[nt] = (f32x4){0.f, 0.f, 0.f, 0.f};
#pragma unroll
    for (int dir = 0; dir < 2; ++dir) {
        const bf16_t* qp = H + (tok0 + 16 * tt + fr) * DIN + (dir ? C_ZB : C_ZF) + h * 128 + 8 * g;
        const bf16_t* sp = US + ((size_t)((dir * 8 + b * 4 + h) * 128 + c)) * 16384 + 8 * g;
        bf16x8 qa[4];
#pragma unroll
        for (int ks = 0; ks < 4; ++ks) qa[ks] = as_bf16x8(*(const u32x4*)(qp + 32 * ks));
#pragma unroll
        for (int nt = 0; nt < 4; ++nt)
#pragma unroll
            for (int ks = 0; ks < 4; ++ks) {
                const bf16x8 sb = as_bf16x8(*(const u32x4*)(sp + (64 * eh + 16 * nt + fr) * 128 + 32 * ks));
                acc[nt] = __builtin_amdgcn_mfma_f32_16x16x32_bf16(qa[ks], sb, acc[nt], 0, 0, 0);
            }
    }
    float ssq[4] = {0.f, 0.f, 0.f, 0.f};
#pragma unroll
    for (int nt = 0; nt < 4; ++nt)
#pragma unroll
        for (int rg = 0; rg < 4; ++rg) {
            acc[nt][rg] += bf2f(H[(tok0 + 16 * tt + 4 * g + rg) * DIN + C_QH + h * 128 + 64 * eh + 16 * nt + fr]);
            ssq[rg] += acc[nt][rg] * acc[nt][rg];
        }
#pragma unroll
    for (int rg = 0; rg < 4; ++rg) {
        float v = ssq[rg];
        v += __shfl_xor(v, 1); v += __shfl_xor(v, 2); v += __shfl_xor(v, 4); v += __shfl_xor(v, 8);
        ssq[rg] = v;
    }
    if (fr == 0) {
#pragma unroll
        for (int rg = 0; rg < 4; ++rg) SSQ[eh * 64 + 16 * tt + 4 * g + rg] = ssq[rg];
    }
    __syncthreads();
#pragma unroll
    for (int rg = 0; rg < 4; ++rg) {
        const int t = 16 * tt + 4 * g + rg;
        const float rsn = rsqrtf((SSQ[t] + SSQ[64 + t]) * (1.f / 128.f) + 1e-6f);
#pragma unroll
        for (int nt = 0; nt < 4; ++nt) {
            const int e = h * 128 + 64 * eh + 16 * nt + fr;
            const float gh = bf2f(H[(tok0 + t) * DIN + C_GH + e]);
            CAT[(tok0 + t) * DM + 512 + e] = (bf16_t)f2bf(acc[nt][rg] * rsn * gain[e] * siluf_(gh));
        }
    }
    __syncthreads();
}

#endif
#ifdef OLD_P3
__device__ __forceinline__ void hgrn_state_scan_old(bf16_t* US, const float* DEC, int dry) {
    const int gt = blockIdx.x * NTHREADS + threadIdx.x, GT = gridDim.x * NTHREADS;
    for (int it = gt; it < 16 * 8192; it += GT) {
        const int sidx = it >> 13, rem = (it & 8191) * 2, d = rem & 127, dir = sidx >> 3;
        float s0 = 0.f, s1 = 0.f;
        for (int c0 = 0; c0 < 128; c0 += 8) {
            unsigned u[8]; float2 dc[8];
#pragma unroll
            for (int k = 0; k < 8; ++k) {
                const int c = dir ? (127 - c0 - k) : (c0 + k);
                u[k] = *(const unsigned*)(US + ((size_t)(sidx * 128 + c)) * 16384 + rem);
                dc[k] = *(const float2*)(DEC + ((size_t)(sidx * 128 + c)) * 128 + d);
            }
#pragma unroll
            for (int k = 0; k < 8; ++k) {
                const int c = dir ? (127 - c0 - k) : (c0 + k);
                *(unsigned*)(US + ((size_t)(sidx * 128 + c)) * 16384 + rem) = dry ? u[k] : pk2(s0, s1);
                s0 = dc[k].x * s0 + bf2f(u[k] & 0xffffu); s1 = dc[k].y * s1 + bf2f(u[k] >> 16);
            }
        }
    }
}

#endif
__device__ __forceinline__ void ln_rows(const float* R, const float* gain, const float* bias, float* out) {
    const int lane = threadIdx.x & 63, gw = blockIdx.x * 8 + (threadIdx.x >> 6), GW = gridDim.x * 8;
    f32x4 gv[4], bv[4];
#pragma unroll
    for (int i = 0; i < 4; ++i) { gv[i] = *(const f32x4*)(gain + i * 256 + lane * 4); bv[i] = *(const f32x4*)(bias + i * 256 + lane * 4); }
    for (int row0 = gw * 4; row0 < MROWS; row0 += GW * 4) {
        f32x4 v[4][4]; float s[4], q[4];
#pragma unroll
        for (int r = 0; r < 4; ++r)
#pragma unroll
            for (int i = 0; i < 4; ++i) v[r][i] = *(const f32x4*)(R + (size_t)(row0 + r) * DM + i * 256 + lane * 4);
#pragma unroll
        for (int r = 0; r < 4; ++r) { s[r] = 0.f;
#pragma unroll
            for (int i = 0; i < 4; ++i) s[r] += v[r][i][0] + v[r][i][1] + v[r][i][2] + v[r][i][3]; }
#pragma unroll
        for (int o = 1; o < 64; o <<= 1)
#pragma unroll
            for (int r = 0; r < 4; ++r) s[r] += __shfl_xor(s[r], o);
#pragma unroll
        for (int r = 0; r < 4; ++r) { const float mu = s[r] * (1.f / 1024.f); q[r] = 0.f;
#pragma unroll
            for (int i = 0; i < 4; ++i) { v[r][i] = v[r][i] - mu; q[r] += v[r][i][0] * v[r][i][0] + v[r][i][1] * v[r][i][1] + v[r][i][2] * v[r][i][2] + v[r][i][3] * v[r][i][3]; } }
#pragma unroll
        for (int o = 1; o < 64; o <<= 1)
#pragma unroll
            for (int r = 0; r < 4; ++r) q[r] += __shfl_xor(q[r], o);
#pragma unroll
        for (int r = 0; r < 4; ++r) { const float rsd = rsqrtf(q[r] * (1.f / 1024.f) + 1e-5f);
#pragma unroll
            for (int i = 0; i < 4; ++i) __builtin_nontemporal_store(v[r][i] * rsd * gv[i] + bv[i], (f32x4*)(out + (size_t)(row0 + r) * DM + i * 256 + lane * 4)); }
    }
}

#define XB_TMO      128
#define XB_XCNT(j)  (256  + 64 * (j))
#define XB_XSUB(j)  (1280 + 64 * (j))
#define XB_XGEN(j)  (2304 + 64 * (j))
#define XB_TOP      3328
#define XB_TOPGEN   3392
#define XCD_BAR_WORDS 3456
#define XB_SPIN_CAP (1u << 18)
__device__ __forceinline__ unsigned xb_ld(unsigned* p)              { return __hip_atomic_load(p, __ATOMIC_RELAXED, __HIP_MEMORY_SCOPE_AGENT); }
__device__ __forceinline__ unsigned xb_add(unsigned* p, unsigned v) { return __hip_atomic_fetch_add(p, v, __ATOMIC_RELAXED, __HIP_MEMORY_SCOPE_AGENT); }
__device__ __forceinline__ unsigned xb_xcc_id() { return (unsigned)__builtin_amdgcn_s_getreg((3 << 11) | 20) & 0xFu; }
#define XB_SPIN(cond, bar) do { unsigned _sp = 0; while (cond) { __builtin_amdgcn_s_sleep(1); \
    if ((++_sp & 255u) == 0u) { if (xb_ld(&(bar)[XB_TMO])) break; if (_sp > XB_SPIN_CAP) { atomicAdd(&(bar)[XB_TMO], 1u); break; } } } } while (0)
struct XcdBarrier { unsigned* bar; unsigned x; volatile LAS unsigned* st; };
__device__ __forceinline__ XcdBarrier xcd_barrier_post(unsigned* bar, volatile LAS unsigned* st) {
    XcdBarrier b; b.bar = bar; b.x = xb_xcc_id(); b.st = st;
    if (threadIdx.x == 0) (void)xb_add(&bar[XB_XCNT(b.x)], 1u);
    return b;
}
__device__ __forceinline__ void xcd_barrier_complete(unsigned* bar, unsigned x, unsigned& nloc, unsigned& nx) {
    const unsigned G = gridDim.x * gridDim.y * gridDim.z;
    unsigned sum, cnt, mine, sp = 0u;
    for (;;) {
        sum = 0u; cnt = 0u; mine = 0u;
#pragma unroll
        for (unsigned j = 0; j < 16; ++j) { const unsigned c = xb_ld(&bar[XB_XCNT(j)]); sum += c; cnt += (c > 0u) ? 1u : 0u; mine = (j == x) ? c : mine; }
        if (sum == G) break;
        __builtin_amdgcn_s_sleep(1);
        if ((++sp & 255u) == 0u) { if (xb_ld(&bar[XB_TMO])) break; if (sp > XB_SPIN_CAP) { atomicAdd(&bar[XB_TMO], 1u); break; } }
    }
    nloc = mine > 0u ? mine : 1u; nx = cnt > 0u ? cnt : 1u;
}
__device__ __forceinline__ void xcd_barrier(const XcdBarrier& b) {
    asm volatile("s_waitcnt vmcnt(0)" ::: "memory");
    __syncthreads();
    if (threadIdx.x == 0) {
        unsigned* bar = b.bar;
        __builtin_amdgcn_s_waitcnt(0);
        unsigned nloc = b.st[0], nx = b.st[1];
        if (nloc == 0u) { xcd_barrier_complete(bar, b.x, nloc, nx); b.st[0] = nloc; b.st[1] = nx; }
        const unsigned old = xb_add(&bar[XB_XSUB(b.x)], 1u);
        const unsigned gen = old / nloc;
        if (old + 1u == (gen + 1u) * nloc) {
            __builtin_amdgcn_fence(__ATOMIC_RELEASE, "agent");
            asm volatile("s_waitcnt vmcnt(0)" ::: "memory");
            const unsigned og = xb_add(&bar[XB_TOP], 1u);
            const unsigned tg = og / nx;
            if (og + 1u == (tg + 1u) * nx) xb_add(&bar[XB_TOPGEN], 1u);
            else XB_SPIN(xb_ld(&bar[XB_TOPGEN]) == tg, bar);
            __builtin_amdgcn_fence(__ATOMIC_ACQUIRE, "agent");
            xb_add(&bar[XB_XGEN(b.x)], 1u);
            asm volatile("s_waitcnt vmcnt(0)" ::: "memory");
        } else {
            XB_SPIN(xb_ld(&bar[XB_XGEN(b.x)]) == gen, bar);
            __builtin_amdgcn_fence(__ATOMIC_ACQUIRE, "agent");
            asm volatile("s_waitcnt vmcnt(0)" ::: "memory");
        }
    }
    __syncthreads();
}

__global__ void __launch_bounds__(NTHREADS, 2) fwd_kernel(Args args) {
    extern __shared__ __attribute__((aligned(16))) unsigned char lds_raw[];
    LAS unsigned char* lds = (LAS unsigned char*)lds_raw;
    unsigned char* ws = args.ws;
    bf16_t* US = (bf16_t*)(ws + WS_US); bf16_t* XB = (bf16_t*)(ws + WS_US); float* R = (float*)(ws + WS_US);
    bf16_t* WIN = (bf16_t*)(ws + WS_WIN); bf16_t* WOUT = (bf16_t*)(ws + WS_WOUT); float* DEC = (float*)(ws + WS_DEC);
    bf16_t* H = (bf16_t*)(ws + WS_H); bf16_t* CAT = (bf16_t*)(ws + WS_CAT);
    const float* x = args.in[0]; const float* w_in = args.in[1]; const float* b_in = args.in[2]; const float* rpb = args.in[3];
    const float* lbf = args.in[4]; const float* lbb = args.in[5]; const float* hgain = args.in[6]; const float* w_out = args.in[7];
    const float* b_out = args.in[8]; const float* ln_g = args.in[9]; const float* ln_b = args.in[10];
    const int G = gridDim.x, bx = blockIdx.x;
    const int vcu = (G % 8 == 0) ? (bx % 8) * (G / 8) + bx / 8 : bx;
    const int lo = args.ph_lo, hi = args.ph_hi;
#define IN(k) (lo <= (k) && (k) < hi)
    volatile LAS unsigned* bst = (volatile LAS unsigned*)(lds + LDS_BYTES - 64);
    if (threadIdx.x == 0) { bst[0] = 0u; bst[1] = 0u; }
    __syncthreads();
    XcdBarrier bar; bar.bar = (unsigned*)(ws + WS_CTL); bar.x = 0; bar.st = bst;
    if (args.coop) bar = xcd_barrier_post((unsigned*)(ws + WS_CTL), bst);
#define SEAM(k) do { if (args.coop && IN(k) && IN((k) + 1)) xcd_barrier(bar); } while (0)
    if (IN(0)) p0_convert(x, w_in, w_out, XB, WIN, WOUT);
    SEAM(0);
    if (IN(1)) {
        pg8::Gemm gm{XB, WIN, MROWS, DIN, DM}; pg8::StaticOrder so; so.init(MROWS, DIN, G, vcu);
        EpiH ep{H, b_in};
        pg8::gemm_phase<EpiH, pg8::StaticOrder, true, true>(lds, gm, so, ep);
    }
    SEAM(1);
    if (IN(2)) {
        for (int at = bx; at < 1024; at += G) { const int a2 = (at % 256) * 4 + at / 256; attn_tile(lds, H, rpb, CAT, a2); }
#ifndef NO_HG
#ifdef OLD_P2B
        if (args.pad == 0) for (int ht = bx; ht < 1024; ht += G) hgrn_local_tile(lds, H, lbf, lbb, US, DEC, ht);
#else
        if (args.pad == 0) hgrn_local_phase(lds, H, lbf, lbb, US, DEC, bx, G);
#endif
#endif
    }
    SEAM(2);
#ifdef OLD_P3
    if (IN(3)) hgrn_state_scan_old(US, DEC, args.pad);
#else
    if (IN(3)) hgrn_state_scan(US, DEC, args.pad);
#endif
    SEAM(3);
#ifdef OLD_P4
    if (IN(4)) { for (int ht = bx; ht < 1024; ht += G) hgrn_out_tile(lds, H, US, hgain, CAT, ht); }
#else
    if (IN(4)) hgrn_out_phase(H, US, hgain, CAT, bx, G);
#endif
    SEAM(4);
    if (IN(5)) {
        pg8::Gemm gm{CAT, WOUT, MROWS, DM, DM}; pg8::StaticOrder so; so.init(MROWS, DM, G, vcu);
        EpiR ep{R, b_out, x};
        pg8::gemm_phase<EpiR, pg8::StaticOrder, false, true>(lds, gm, so, ep);
    }
    SEAM(5);
    if (IN(6)) ln_rows(R, ln_g, ln_b, args.out);
#undef IN
#undef SEAM
}

extern "C" void kernel_launch(void* const* d_in, const int* in_sizes, int n_in, void* d_out, int out_size, void* d_ws, size_t ws_size, hipStream_t stream) {
    static int grid = 0;
    if (grid == 0) {
        int dev = 0, cus = 0, per_cu = 0;
        if (hipGetDevice(&dev) != hipSuccess || hipDeviceGetAttribute(&cus, hipDeviceAttributeMultiprocessorCount, dev) != hipSuccess) { fprintf(stderr, "kernel_launch: device query failed\n"); grid = -1; return; }
        if (hipFuncSetAttribute((const void*)fwd_kernel, hipFuncAttributeMaxDynamicSharedMemorySize, LDS_BYTES) != hipSuccess) { fprintf(stderr, "kernel_launch: hipFuncSetAttribute failed\n"); grid = -1; return; }
        if (hipOccupancyMaxActiveBlocksPerMultiprocessor(&per_cu, (const void*)fwd_kernel, NTHREADS, LDS_BYTES) != hipSuccess || per_cu < 1) { fprintf(stderr, "kernel_launch: occupancy query gave %d\n", per_cu); per_cu = 1; }
        (void)hipGetLastError();
        if (per_cu > 1) per_cu = 1;
        grid = cus * per_cu;
        if (ws_size < 256 * MiB) fprintf(stderr, "kernel_launch: workspace too small (%zu)\n", ws_size);
    }
    if (grid < 0) return;
    Args a{};
    for (int i = 0; i < 11; ++i) a.in[i] = (const float*)d_in[i];
    a.out = (float*)d_out; a.ws = (unsigned char*)d_ws;
#if MK_LAUNCHES == 1
    a.ph_lo = 0; a.ph_hi = 7; a.coop = 1;
    if (hipMemsetAsync((char*)d_ws + WS_CTL, 0, 16384, stream) != hipSuccess) { fprintf(stderr, "kernel_launch: memset failed\n"); return; }
    hipLaunchKernelGGL(fwd_kernel, dim3(grid), dim3(NTHREADS), LDS_BYTES, stream, a);
#else
    for (int p = 0; p < 7; ++p) {
        a.ph_lo = p; a.ph_hi = p + 1; a.coop = 0;
        int reps = 1;
#ifdef PROBE_PHASE
        if (p == PROBE_PHASE) reps = 1 + PROBE_N;
#endif
        for (int q = 0; q < reps; ++q) { a.pad = ((p == 2 || p == 3) && q + 1 < reps) ? 1 : 0; hipLaunchKernelGGL(fwd_kernel, dim3(grid), dim3(NTHREADS), LDS_BYTES, stream, a); }
    }
#endif
}
```

```cpp
#include <hip/hip_runtime.h>
#include <hip/hip_cooperative_groups.h>
#include <cstdio>
#include <cstdint>
namespace cg = cooperative_groups;
#define MK_LAUNCHES 1
namespace pg8 {
#define PG8_LAS __attribute__((address_space(3)))
typedef unsigned short bf16_t;
typedef short bf16x8 __attribute__((ext_vector_type(8)));
typedef float f32x4 __attribute__((ext_vector_type(4)));
typedef unsigned u32x4 __attribute__((ext_vector_type(4)));
constexpr int BM = 256, BK = 64, HALF = 128, HTB = HALF * BK * 2  , STAGE_BYTES = 8 * HTB, NXCD = 8, WGM = 8;

__host__ __device__ __forceinline__ int lds_byte(int r, int c) { const int st = (r >> 4) * 2 + (c >> 5), rr = r & 15, cc = c & 31, ob = rr * 64 + cc * 2; return st * 1024 + (ob ^ (((ob >> 9) & 1) << 5)); }
__host__ __device__ __forceinline__ void stage_rc(int b, int& R, int& C) { const int st = b / 1024, sb = b % 1024, swz = sb ^ (((sb >> 9) & 1) << 5); R = (st >> 1) * 16 + swz / 64; C = (st & 1) * 32 + (swz % 64) / 2; }
__host__ __device__ __forceinline__ int perm32(int rho) { const int n = rho >> 4, i = rho & 15; return 8 * (i >> 2) + 4 * n + (i & 3); }

struct Unit { int pm, pn; };
struct Gemm { const bf16_t* A; const bf16_t* Bt; int M, N, K; };

struct StaticOrder {
    int nM, nN, nwg, G, c;
    __host__ __device__ void init(int M, int N, int G_, int c_) { nM = M / BM; nN = N / BM; nwg = nM * nN; G = G_; c = c_; }
    __host__ __device__ bool next(int i, Unit& u) const {
        const long L = (long)i * G + c; if (L >= nwg) return false;
        int wgid = (int)L; { const int q = nwg / NXCD, r = nwg % NXCD, xcd = wgid % NXCD, off = wgid / NXCD; wgid = (xcd < r ? xcd * (q + 1) : r * (q + 1) + (xcd - r) * q) + off; }
        const int nig = WGM * nN, gid = wgid / nig, fm = gid * WGM, gsz = (nM - fm) < WGM ? (nM - fm) : WGM;
        u.pm = fm + ((wgid % nig) % gsz); u.pn = (wgid % nig) / gsz; return true;
    }
    __device__ __forceinline__ void a_ready(const Unit&) const {}
    __device__ __forceinline__ void done(const Unit&) const {}
};
__device__ __forceinline__ unsigned cvt_pk_bf16(float lo, float hi) { unsigned r; asm volatile("v_cvt_pk_bf16_f32 %0, %1, %2" : "=v"(r) : "v"(lo), "v"(hi)); return r; }
template <class Epi, class Sched, bool ALIGN_EPI = false, bool SP2 = false>
__device__ __forceinline__ void gemm_phase(PG8_LAS unsigned char* lds, const Gemm g, const Sched& S, const Epi& E) {
    const int tid = threadIdx.x, wid = __builtin_amdgcn_readfirstlane(tid >> 6), lane = tid & 63, wr = wid >> 2, wc = wid & 3, fr = lane & 15, fq = lane >> 4;
    const int K = g.K, nt = K / BK;
    unsigned voffA[2], voffB[2];
#pragma unroll
    for (int i = 0; i < 2; ++i) { int R, C; stage_rc(tid * 16 + i * 8192, R, C); const int Rb = Epi::PERM ? ((R & ~31) + perm32(R & 31)) : R;
        voffA[i] = (unsigned)(R * K + C) * 2u; voffB[i] = (unsigned)(Rb * K + C) * 2u; }
    const size_t kstep = (size_t)(BK * 2);
    const size_t hstep = (size_t)HALF * K * 2;
    const size_t tstep = 2 * hstep;
    const unsigned ldsw = (unsigned)wid * 1024u;
    const int aoff = lds_byte(wr * 64 + fr, fq * 8), boff = lds_byte(wc * 32 + fr, fq * 8);
#define PG8_SA(b, h) (((b) * 2 + (h)) * HTB)
#define PG8_SB(b, h) ((4 + (b) * 2 + (h)) * HTB)
#define PG8_STAGE(bufoff, gbase, voff) do { _Pragma("unroll") for (int _i = 0; _i < 2; ++_i) \
        __builtin_amdgcn_global_load_lds((const unsigned*)((const char*)(gbase) + (voff)[_i]), (PG8_LAS unsigned*)(lds + (bufoff) + ldsw + _i * 8192), 16, 0, 0); } while (0)
#define PG8_LDA(dst, b, h) do { _Pragma("unroll") for (int m = 0; m < 4; ++m) _Pragma("unroll") for (int k = 0; k < 2; ++k) dst[m][k] = *(const PG8_LAS bf16x8*)(lds + PG8_SA(b, h) + aoff + m * 2048 + k * 1024); } while (0)
#define PG8_LDB(dst, b, h) do { _Pragma("unroll") for (int n = 0; n < 2; ++n) _Pragma("unroll") for (int k = 0; k < 2; ++k) dst[n][k] = *(const PG8_LAS bf16x8*)(lds + PG8_SB(b, h) + boff + n * 2048 + k * 1024); } while (0)
#define PG8_MMA(ai, bj, At, Bt) do { __builtin_amdgcn_s_setprio(1); _Pragma("unroll") for (int m = 0; m < 4; ++m) _Pragma("unroll") for (int n = 0; n < 2; ++n) _Pragma("unroll") for (int k = 0; k < 2; ++k) \
        acc[ai][bj][m][n] = __builtin_amdgcn_mfma_f32_16x16x32_bf16(Bt[n][k], At[m][k], acc[ai][bj][m][n], 0, 0, 0); __builtin_amdgcn_s_setprio(0); } while (0)
#define PG8_WAIT_V(n) asm volatile("s_waitcnt vmcnt(" #n ")" ::: "memory")
#define PG8_WAIT_L(n) asm volatile("s_waitcnt lgkmcnt(" #n ")" ::: "memory")
#define PG8_BAR __builtin_amdgcn_s_barrier()
#define PG8_SCHED __builtin_amdgcn_sched_barrier(0)
    Unit cur, nxt; int ui = 0;
    if (!S.next(0, cur)) return;
    f32x4 acc[2][2][4][2];
#pragma unroll
    for (int a = 0; a < 2; ++a)
#pragma unroll
        for (int b = 0; b < 2; ++b)
#pragma unroll
            for (int m = 0; m < 4; ++m)
#pragma unroll
                for (int n = 0; n < 2; ++n) acc[a][b][m][n] = (f32x4){0.f, 0.f, 0.f, 0.f};
    bf16x8 At[4][2], B0[2][2], B1[2][2];
    const char* cA = (const char*)g.A + (size_t)cur.pm * tstep; const char* cB = (const char*)g.Bt + (size_t)cur.pn * tstep;
    S.a_ready(cur);
    if constexpr (SP2) {
        PG8_STAGE(PG8_SB(0, 0), cB, voffB); PG8_STAGE(PG8_SB(0, 1), cB + hstep, voffB); PG8_STAGE(PG8_SA(0, 0), cA, voffA); PG8_STAGE(PG8_SA(0, 1), cA + hstep, voffA);
        if (wr == 1) PG8_BAR;
        PG8_WAIT_V(2); PG8_BAR;
        PG8_STAGE(PG8_SB(1, 0), cB + kstep, voffB); PG8_STAGE(PG8_SA(1, 0), cA + kstep, voffA); PG8_STAGE(PG8_SB(1, 1), cB + hstep + kstep, voffB);
        PG8_WAIT_V(6); PG8_BAR;
    } else {
        PG8_STAGE(PG8_SB(0, 0), cB, voffB); PG8_STAGE(PG8_SA(0, 0), cA, voffA); PG8_STAGE(PG8_SB(0, 1), cB + hstep, voffB); PG8_STAGE(PG8_SA(0, 1), cA + hstep, voffA);
        if (wr == 1) PG8_BAR;
        PG8_WAIT_V(4); PG8_BAR;
        PG8_STAGE(PG8_SB(1, 0), cB + kstep, voffB); PG8_STAGE(PG8_SA(1, 0), cA + kstep, voffA); PG8_STAGE(PG8_SB(1, 1), cB + hstep + kstep, voffB);
        PG8_WAIT_V(6); PG8_BAR;
    }
    for (;;) {
        const bool has_next = S.next(ui + 1, nxt);
        const char* nA = has_next ? (const char*)g.A + (size_t)nxt.pm * tstep : cA; const char* nB = has_next ? (const char*)g.Bt + (size_t)nxt.pn * tstep : cB;
        for (int t = 0; t < nt; t += 2) {
            const bool last = (t == nt - 2);
            const char* a1 = cA + (size_t)(t + 1) * kstep;
            const char* a2 = last ? nA : cA + (size_t)(t + 2) * kstep; const char* b2 = last ? nB : cB + (size_t)(t + 2) * kstep;
            const char* a3 = a2 + kstep; const char* b3 = b2 + kstep;
            if (last && has_next) S.a_ready(nxt);
            if constexpr (SP2) {
            PG8_LDB(B0, 0, 0); PG8_LDB(B1, 0, 1); PG8_SCHED; PG8_LDA(At, 0, 0); PG8_STAGE(PG8_SA(1, 1), a1 + hstep, voffA);
            PG8_WAIT_V(8); PG8_WAIT_L(0); PG8_BAR; PG8_MMA(0, 0, At, B0); PG8_MMA(0, 1, At, B1); PG8_BAR; PG8_SCHED;
            PG8_LDA(At, 0, 1); PG8_STAGE(PG8_SB(0, 0), b2, voffB); PG8_STAGE(PG8_SB(0, 1), b2 + hstep, voffB); PG8_STAGE(PG8_SA(0, 0), a2, voffA);
            PG8_WAIT_V(8); PG8_WAIT_L(0); PG8_BAR; PG8_MMA(1, 0, At, B0); PG8_MMA(1, 1, At, B1); PG8_BAR; PG8_SCHED;
            PG8_LDB(B0, 1, 0); PG8_LDB(B1, 1, 1); PG8_SCHED; PG8_LDA(At, 1, 0); PG8_STAGE(PG8_SA(0, 1), a2 + hstep, voffA);
            PG8_WAIT_V(8); PG8_WAIT_L(0); PG8_BAR; PG8_MMA(0, 0, At, B0); PG8_MMA(0, 1, At, B1); PG8_BAR; PG8_SCHED;
            PG8_LDA(At, 1, 1); PG8_STAGE(PG8_SB(1, 0), b3, voffB); PG8_STAGE(PG8_SB(1, 1), b3 + hstep, voffB); PG8_STAGE(PG8_SA(1, 0), a3, voffA);
            PG8_WAIT_V(8); PG8_WAIT_L(0); PG8_BAR; PG8_MMA(1, 0, At, B0); PG8_MMA(1, 1, At, B1); PG8_BAR; PG8_SCHED;
            } else {
            PG8_LDB(B0, 0, 0); PG8_SCHED; PG8_LDA(At, 0, 0); PG8_STAGE(PG8_SA(1, 1), a1 + hstep, voffA);
            PG8_WAIT_L(8); PG8_BAR; PG8_WAIT_L(0); PG8_MMA(0, 0, At, B0); PG8_BAR; PG8_SCHED;
            PG8_LDB(B1, 0, 1); PG8_STAGE(PG8_SB(0, 0), b2, voffB);
            PG8_BAR; PG8_WAIT_L(0); PG8_MMA(0, 1, At, B1); PG8_BAR;
            PG8_LDA(At, 0, 1); PG8_STAGE(PG8_SA(0, 0), a2, voffA);
            PG8_BAR; PG8_WAIT_L(0); PG8_MMA(1, 0, At, B0); PG8_BAR; PG8_SCHED;
            PG8_STAGE(PG8_SB(0, 1), b2 + hstep, voffB);
            PG8_WAIT_V(6); PG8_BAR; PG8_MMA(1, 1, At, B1); PG8_BAR;
            PG8_LDB(B0, 1, 0); PG8_SCHED; PG8_LDA(At, 1, 0); PG8_STAGE(PG8_SA(0, 1), a2 + hstep, voffA);
            PG8_WAIT_L(8); PG8_BAR; PG8_WAIT_L(0); PG8_MMA(0, 0, At, B0); PG8_BAR; PG8_SCHED;
            PG8_LDB(B1, 1, 1); PG8_STAGE(PG8_SB(1, 0), b3, voffB);
            PG8_BAR; PG8_WAIT_L(0); PG8_MMA(0, 1, At, B1); PG8_BAR;
            PG8_LDA(At, 1, 1); PG8_STAGE(PG8_SA(1, 0), a3, voffA);
            PG8_BAR; PG8_WAIT_L(0); PG8_MMA(1, 0, At, B0); PG8_BAR; PG8_SCHED;
            PG8_STAGE(PG8_SB(1, 1), b3 + hstep, voffB);
            PG8_WAIT_V(6); PG8_BAR; PG8_MMA(1, 1, At, B1); PG8_BAR;
            }
        }
        if constexpr (ALIGN_EPI) { if (wr == 0) PG8_BAR; }
        if constexpr (!Epi::AFTER_DRAIN) { E(acc, cur, wr, wc, fr, fq); S.done(cur); }
        if (!has_next) break;
#pragma unroll
        for (int a = 0; a < 2; ++a)
#pragma unroll
            for (int b = 0; b < 2; ++b)
#pragma unroll
                for (int m = 0; m < 4; ++m)
#pragma unroll
                    for (int n = 0; n < 2; ++n) acc[a][b][m][n] = (f32x4){0.f, 0.f, 0.f, 0.f};
        cur = nxt; cA = nA; cB = nB; ++ui;
        if constexpr (ALIGN_EPI) { if (wr == 1) PG8_BAR; }
    }
    PG8_WAIT_V(0);
    if constexpr (!ALIGN_EPI) { if (wr == 0) PG8_BAR; }
    PG8_BAR;
    if constexpr (Epi::AFTER_DRAIN) { E.fused(acc, cur, wr, wc, fr, fq, lds, wid, lane); S.done(cur); }
#undef PG8_SA
#undef PG8_SB
#undef PG8_STAGE
#undef PG8_LDA
#undef PG8_LDB
#undef PG8_MMA
#undef PG8_WAIT_V
#undef PG8_WAIT_L
#undef PG8_BAR
#undef PG8_SCHED
}
}

#ifndef MK_LAUNCHES
#define MK_LAUNCHES 1
#endif
#define LAS __attribute__((address_space(3)))
typedef unsigned short bf16_t;
typedef short bf16x8 __attribute__((ext_vector_type(8)));
typedef float f32x4 __attribute__((ext_vector_type(4)));
typedef unsigned u32x4 __attribute__((ext_vector_type(4)));
typedef unsigned u32x2 __attribute__((ext_vector_type(2)));

constexpr int NTHREADS = 512;
constexpr int BATCH = 2, SEQ = 8192, DM = 1024, MROWS = BATCH * SEQ, DIN = 4608;
constexpr int C_QA = 0, C_KA = 512, C_VA = 1024, C_GA = 1536, C_QH = 2048, C_ZF = 2560, C_ZB = 3072, C_IH = 3584, C_GH = 4096;
constexpr float ALPHA = 1.189207115002721f;
constexpr size_t MiB = 1u << 20;
constexpr size_t WS_US = 0;
constexpr size_t WS_WIN = 64 * MiB, WS_WOUT = 73 * MiB, WS_DEC = 75 * MiB, WS_CTL = 77 * MiB;
constexpr size_t WS_H = 80 * MiB;
constexpr size_t WS_CAT = 224 * MiB;
constexpr int LDS_BYTES = 158720;

struct Args { const float* in[11]; float* out; unsigned char* ws; int ph_lo, ph_hi, coop, pad; };

__device__ __forceinline__ float bf2f(unsigned v) { return __builtin_bit_cast(float, v << 16); }
__device__ __forceinline__ unsigned f2bf(float f) { unsigned u = __builtin_bit_cast(unsigned, f); return (u + 0x7fffu + ((u >> 16) & 1u)) >> 16; }
typedef float f32x2_t __attribute__((ext_vector_type(2)));
typedef __bf16 bf16x2_t __attribute__((ext_vector_type(2)));
__device__ __forceinline__ unsigned pk2(float lo, float hi) { f32x2_t v = {lo, hi}; bf16x2_t b = __builtin_convertvector(v, bf16x2_t); return __builtin_bit_cast(unsigned, b); }
__device__ __forceinline__ float sigmoidf_(float z) { return 1.f / (1.f + __expf(-z)); }
__device__ __forceinline__ float siluf_(float z) { return z / (1.f + __expf(-z)); }
__device__ __forceinline__ bf16x8 as_bf16x8(u32x4 v) { return __builtin_bit_cast(bf16x8, v); }

struct EpiH {
    static constexpr bool PERM = true, AFTER_DRAIN = false;
    bf16_t* O; const float* bias;
    __device__ __forceinline__ void operator()(const f32x4 (&acc)[2][2][4][2], const pg8::Unit& u, int wr, int wc, int fr, int fq) const {
        const int row0 = u.pm * 256 + wr * 64 + fr, col0 = u.pn * 256 + wc * 32 + 8 * fq;
        f32x4 bv[2][2];
#pragma unroll
        for (int bj = 0; bj < 2; ++bj)
#pragma unroll
            for (int n = 0; n < 2; ++n) bv[bj][n] = *(const f32x4*)(bias + col0 + bj * 128 + 4 * n);
#pragma unroll
        for (int ai = 0; ai < 2; ++ai)
#pragma unroll
            for (int m = 0; m < 4; ++m) { bf16_t* rowp = O + (size_t)(row0 + ai * 128 + m * 16) * DIN + col0;
#pragma unroll
                for (int bj = 0; bj < 2; ++bj) { f32x4 v0 = acc[ai][bj][m][0] + bv[bj][0], v1 = acc[ai][bj][m][1] + bv[bj][1];
                    u32x4 w; w.x = pk2(v0[0], v0[1]); w.y = pk2(v0[2], v0[3]); w.z = pk2(v1[0], v1[1]); w.w = pk2(v1[2], v1[3]);
                    *(u32x4*)(rowp + bj * 128) = w; } }
    }
};
struct EpiR {
    static constexpr bool PERM = false, AFTER_DRAIN = false;
    float* R; const float* bias; const float* x;
    __device__ __forceinline__ void operator()(const f32x4 (&acc)[2][2][4][2], const pg8::Unit& u, int wr, int wc, int fr, int fq) const {
        const int row0 = u.pm * 256 + wr * 64 + fr, col0 = u.pn * 256 + wc * 32 + 4 * fq;
        f32x4 bv[2][2];
#pragma unroll
        for (int bj = 0; bj < 2; ++bj)
#pragma unroll
            for (int n = 0; n < 2; ++n) bv[bj][n] = *(const f32x4*)(bias + col0 + bj * 128 + n * 16);
#pragma unroll
        for (int ai = 0; ai < 2; ++ai)
#pragma unroll
            for (int m = 0; m < 4; ++m) { const size_t ro = (size_t)(row0 + ai * 128 + m * 16) * DM + col0;
#pragma unroll
                for (int bj = 0; bj < 2; ++bj)
#pragma unroll
                    for (int n = 0; n < 2; ++n) { const f32x4 xv = *(const f32x4*)(x + ro + bj * 128 + n * 16);
                        *(f32x4*)(R + ro + bj * 128 + n * 16) = acc[ai][bj][m][n] + bv[bj][n] + xv * ALPHA; } }
    }
};

__device__ __forceinline__ void p0_convert(const float* x, const float* w_in, const float* w_out, bf16_t* XB, bf16_t* WIN, bf16_t* WOUT) {
    const int gt = blockIdx.x * NTHREADS + threadIdx.x, GT = gridDim.x * NTHREADS;
    for (int i = gt; i < MROWS * DM / 8; i += 4 * GT) {
        f32x4 a[4], b[4];
#pragma unroll
        for (int k = 0; k < 4; ++k) if (i + k * GT < MROWS * DM / 8) { const size_t o = (size_t)(i + k * GT) * 8; a[k] = __builtin_nontemporal_load((const f32x4*)(x + o)); b[k] = __builtin_nontemporal_load((const f32x4*)(x + o + 4)); }
#pragma unroll
        for (int k = 0; k < 4; ++k) if (i + k * GT < MROWS * DM / 8) { u32x4 w; w.x = pk2(a[k][0], a[k][1]); w.y = pk2(a[k][2], a[k][3]); w.z = pk2(b[k][0], b[k][1]); w.w = pk2(b[k][2], b[k][3]);
            *(u32x4*)(XB + (size_t)(i + k * GT) * 8) = w; }
    }
    for (int i = gt; i < DIN * 128; i += GT) {
        const int n = i % DIN, kb = i / DIN; float v[8];
#pragma unroll
        for (int j = 0; j < 8; ++j) v[j] = w_in[(size_t)(kb * 8 + j) * DIN + n];
        u32x4 w; w.x = pk2(v[0], v[1]); w.y = pk2(v[2], v[3]); w.z = pk2(v[4], v[5]); w.w = pk2(v[6], v[7]);
        *(u32x4*)(WIN + (size_t)n * 1024 + kb * 8) = w;
    }
    for (int i = gt; i < DM * 128; i += GT) {
        const int n = i % DM, kb = i / DM; float v[8];
#pragma unroll
        for (int j = 0; j < 8; ++j) v[j] = w_out[(size_t)(kb * 8 + j) * DM + n];
        u32x4 w; w.x = pk2(v[0], v[1]); w.y = pk2(v[2], v[3]); w.z = pk2(v[4], v[5]); w.w = pk2(v[6], v[7]);
        *(u32x4*)(WOUT + (size_t)n * 1024 + kb * 8) = w;
    }
}

constexpr int AT_VP = 520;
constexpr int AT_RPB_OFF = 2 * 64 * AT_VP * 2;
__device__ __forceinline__ void attn_tile(LAS unsigned char* lds, const bf16_t* H, const float* rpb, bf16_t* CAT, int at) {
    const int tid = threadIdx.x, lane = tid & 63, w = tid >> 6, fr = lane & 15, g = lane >> 4;
    const int b = at >> 9, hp = (at >> 7) & 3, r = at & 127;
    int rs = r - 4; rs = rs < 0 ? 0 : (rs > 120 ? 120 : rs);
    LAS bf16_t* VT = (LAS bf16_t*)lds;
    LAS float* RPB = (LAS float*)(lds + AT_RPB_OFF);
    {
        const size_t tok = (size_t)b * SEQ + (size_t)(rs + (tid >> 6)) * 64 + (tid & 63);
#pragma unroll
        for (int hh = 0; hh < 2; ++hh) {
            const bf16_t* src = H + tok * DIN + C_VA + (2 * hp + hh) * 64;
#pragma unroll
            for (int p = 0; p < 8; ++p) {
                const u32x4 v = *(const u32x4*)(src + 8 * p);
#pragma unroll
                for (int i = 0; i < 4; ++i) {
                    VT[(hh * 64 + 8 * p + 2 * i) * AT_VP + tid] = (bf16_t)(v[i] & 0xffffu);
                    VT[(hh * 64 + 8 * p + 2 * i + 1) * AT_VP + tid] = (bf16_t)(v[i] >> 16);
                }
            }
        }
        for (int i = tid; i < 930; i += NTHREADS) RPB[i] = rpb[hp * 930 + i];
    }
    __syncthreads();
    const int hh = w >> 2, j = w & 3, head = 2 * hp + hh;
    const int kc0 = (j == 0) ? 0 : (j == 1 ? 8 : (j == 2 ? 24 : 32));
    const size_t qtok = (size_t)b * SEQ + (size_t)r * 64 + 16 * j + fr;
    bf16x8 qf[2];
#pragma unroll
    for (int ks = 0; ks < 2; ++ks) qf[ks] = as_bf16x8(*(const u32x4*)(H + qtok * DIN + C_QA + head * 64 + ks * 32 + 8 * g));
    f32x4 S[16];
#pragma unroll
    for (int kt = 0; kt < 16; ++kt) {
        const int a = kt >> 1, ch = kt & 1;
        const size_t ktok = (size_t)b * SEQ + (size_t)(rs + a) * 64 + kc0 + 16 * ch + fr;
        const bf16_t* kp = H + ktok * DIN + C_KA + head * 64 + 8 * g;
        const bf16x8 k0 = as_bf16x8(*(const u32x4*)(kp)), k1 = as_bf16x8(*(const u32x4*)(kp + 32));
        f32x4 acc = {0.f, 0.f, 0.f, 0.f};
        acc = __builtin_amdgcn_mfma_f32_16x16x32_bf16(k0, qf[0], acc, 0, 0, 0);
        acc = __builtin_amdgcn_mfma_f32_16x16x32_bf16(k1, qf[1], acc, 0, 0, 0);
        S[kt] = acc;
    }
    const int qcol = 16 * j + fr;
    int cs = qcol - 8; cs = cs < 0 ? 0 : (cs > 48 ? 48 : cs);
    float mx = -1e30f;
#pragma unroll
    for (int kt = 0; kt < 16; ++kt) {
        const int a = kt >> 1, ch = kt & 1;
        const int dr = rs + a - r + 7;
#pragma unroll
        for (int rg = 0; rg < 4; ++rg) {
            const int kcol = kc0 + 16 * ch + 4 * g + rg;
            int dc = kcol - qcol + 15; dc = dc < 0 ? 0 : (dc > 30 ? 30 : dc);
            const bool inw = (unsigned)(kcol - cs) < 16u;
            const float s = S[kt][rg] * 0.125f + RPB[hh * 465 + dr * 31 + dc];
            S[kt][rg] = inw ? s : -1e30f;
            mx = fmaxf(mx, S[kt][rg]);
        }
    }
    mx = fmaxf(mx, __shfl_xor(mx, 16)); mx = fmaxf(mx, __shfl_xor(mx, 32));
    float sum = 0.f;
#pragma unroll
    for (int kt = 0; kt < 16; ++kt)
#pragma unroll
        for (int rg = 0; rg < 4; ++rg) { const float p = __expf(S[kt][rg] - mx); S[kt][rg] = p; sum += p; }
    sum += __shfl_xor(sum, 16); sum += __shfl_xor(sum, 32);
    f32x4 O[4];
#pragma unroll
    for (int mt = 0; mt < 4; ++mt) O[mt] = (f32x4){0.f, 0.f, 0.f, 0.f};
#pragma unroll
    for (int kk = 0; kk < 8; ++kk) {
        u32x4 pw; pw.x = pk2(S[2 * kk][0], S[2 * kk][1]); pw.y = pk2(S[2 * kk][2], S[2 * kk][3]);
        pw.z = pk2(S[2 * kk + 1][0], S[2 * kk + 1][1]); pw.w = pk2(S[2 * kk + 1][2], S[2 * kk + 1][3]);
        const bf16x8 pf = as_bf16x8(pw);
        const int key1 = kk * 64 + kc0 + 4 * g;
#pragma unroll
        for (int mt = 0; mt < 4; ++mt) {
            const LAS bf16_t* vp = VT + (hh * 64 + 16 * mt + fr) * AT_VP + key1;
            const u32x2 lo = *(const LAS u32x2*)(vp), hi = *(const LAS u32x2*)(vp + 16);
            u32x4 vw; vw.x = lo.x; vw.y = lo.y; vw.z = hi.x; vw.w = hi.y;
            O[mt] = __builtin_amdgcn_mfma_f32_16x16x32_bf16(as_bf16x8(vw), pf, O[mt], 0, 0, 0);
        }
    }
    const float inv = 1.f / sum;
#pragma unroll
    for (int mt = 0; mt < 4; ++mt) {
        const int e = 16 * mt + 4 * g;
        const u32x2 gw = *(const u32x2*)(H + qtok * DIN + C_GA + head * 64 + e);
        const float g0 = bf2f(gw.x & 0xffffu), g1 = bf2f(gw.x >> 16), g2 = bf2f(gw.y & 0xffffu), g3 = bf2f(gw.y >> 16);
        u32x2 ow; ow.x = pk2(O[mt][0] * inv * siluf_(g0), O[mt][1] * inv * siluf_(g1)); ow.y = pk2(O[mt][2] * inv * siluf_(g2), O[mt][3] * inv * siluf_(g3));
        *(u32x2*)(CAT + qtok * DM + head * 64 + e) = ow;
    }
    __syncthreads();
}

#ifdef OLD_P2B
constexpr int OHG_QS = 0, OHG_VT = 16384, OHG_LF = 34816, OHG_ZS = 67584, OHG_QT = 83968, OHG_KP = 101376, OHG_KPT = 118784, OHG_TOT = 137216, OHG_DECS = 139264;
constexpr int OHG_VP = 72, OHG_QP = 136;
__device__ __forceinline__ void hgrn_local_tile(LAS unsigned char* lds, bf16_t* H, const float* lbf, const float* lbb, bf16_t* US, float* DEC, int ht) {
    const int tid = threadIdx.x, lane = tid & 63, w = tid >> 6, fr = lane & 15, g = lane >> 4;
    const int b = ht >> 9, h = (ht >> 7) & 3, c = ht & 127;
    const size_t tok0 = (size_t)b * SEQ + (size_t)c * 64;
    LAS bf16_t* QS = (LAS bf16_t*)(lds + OHG_QS); LAS bf16_t* VT = (LAS bf16_t*)(lds + OHG_VT); LAS float* LF = (LAS float*)(lds + OHG_LF);
    LAS bf16_t* ZS = (LAS bf16_t*)(lds + OHG_ZS); LAS bf16_t* QT = (LAS bf16_t*)(lds + OHG_QT); LAS bf16_t* KP = (LAS bf16_t*)(lds + OHG_KP);
    LAS bf16_t* KPT = (LAS bf16_t*)(lds + OHG_KPT); LAS float* TOT = (LAS float*)(lds + OHG_TOT); LAS float* DECS = (LAS float*)(lds + OHG_DECS);
#pragma unroll
    for (int i = 0; i < 2; ++i) {
        const int p = tid + i * NTHREADS, s = p >> 4, d8 = (p & 15) * 8;
        const bf16_t* rowp = H + (tok0 + s) * DIN + h * 128 + d8;
        *(LAS u32x4*)(QS + s * 128 + d8) = *(const u32x4*)(rowp + C_QH);
        const u32x4 v = *(const u32x4*)(rowp + C_IH);
#pragma unroll
        for (int k = 0; k < 4; ++k) { VT[(d8 + 2 * k) * OHG_VP + s] = (bf16_t)(v[k] & 0xffffu); VT[(d8 + 2 * k + 1) * OHG_VP + s] = (bf16_t)(v[k] >> 16); }
    }
    const int d = tid & 127, sq = tid >> 7;
    const int tt = w & 3, eh = w >> 2;
    f32x4 OI[4];
#pragma unroll
    for (int nt = 0; nt < 4; ++nt) OI[nt] = (f32x4){0.f, 0.f, 0.f, 0.f};
    for (int dir = 0; dir < 2; ++dir) {
        const float* lbl = dir ? lbb : lbf;
        const float lb = 1.f / (1.f + __expf(lbl[512 + h * 128 + d] - lbl[h * 128 + d]));
        const int zc = dir ? C_ZB : C_ZF;
#pragma unroll
        for (int i = 0; i < 2; ++i) {
            const int p = tid + i * NTHREADS, s = p >> 4, d8 = (p & 15) * 8;
            *(LAS u32x4*)(ZS + s * 128 + d8) = *(const u32x4*)(H + (tok0 + s) * DIN + zc + h * 128 + d8);
        }
        __syncthreads();
        float kreg[16];
#pragma unroll
        for (int i = 0; i < 16; ++i) {
            const int s = sq + 4 * i;
            const float z = bf2f(ZS[s * 128 + d]);
            const float ez = __expf(-z), sg = 1.f / (1.f + ez);
            const float f = lb + (1.f - lb) * sg;
            LF[s * 128 + d] = __logf(f);
            kreg[i] = (1.f - lb) * (1.f - sg);
        }
        __syncthreads();
        {
            float run = 0.f;
#pragma unroll
            for (int i = 0; i < 16; ++i) {
                const int s = dir ? (16 * sq + 15 - i) : (16 * sq + i);
                run += LF[s * 128 + d]; LF[s * 128 + d] = run;
            }
            TOT[sq * 128 + d] = run;
        }
        __syncthreads();
        {
            const float t0 = TOT[d], t1 = TOT[128 + d], t2 = TOT[256 + d], t3 = TOT[384 + d];
            float pre[4];
            if (dir == 0) { pre[0] = 0.f; pre[1] = t0; pre[2] = t0 + t1; pre[3] = t0 + t1 + t2; }
            else          { pre[3] = 0.f; pre[2] = t3; pre[1] = t3 + t2; pre[0] = t3 + t2 + t1; }
            if (tid < 128) { const float dec = __expf(t0 + t1 + t2 + t3); DECS[d] = dec; DEC[((size_t)((dir * 8 + b * 4 + h) * 128 + c)) * 128 + d] = dec; }
#pragma unroll
            for (int i = 0; i < 16; ++i) {
                const int s = sq + 4 * i;
                const float bb = LF[s * 128 + d] + pre[i >> 2];
                const float eq = __expf(bb), ek = __expf(-bb);
                const float qv = bf2f(QS[s * 128 + d]);
                const bf16_t qt = (bf16_t)f2bf(qv * eq), kp = (bf16_t)f2bf(kreg[i] * ek);
                QT[s * OHG_QP + d] = qt; KP[s * OHG_QP + d] = kp; KPT[d * OHG_VP + s] = kp;
            }
        }
        __syncthreads();
        {
            f32x4 aT[4];
#pragma unroll
            for (int st = 0; st < 4; ++st) {
                f32x4 acc = {0.f, 0.f, 0.f, 0.f};
                const bool live = dir ? (st >= tt) : (st <= tt);
                if (live) {
#pragma unroll
                    for (int ks = 0; ks < 4; ++ks) {
                        const bf16x8 af = *(const LAS bf16x8*)(KP + (16 * st + fr) * OHG_QP + 32 * ks + 8 * g);
                        const bf16x8 bfr = *(const LAS bf16x8*)(QT + (16 * tt + fr) * OHG_QP + 32 * ks + 8 * g);
                        acc = __builtin_amdgcn_mfma_f32_16x16x32_bf16(af, bfr, acc, 0, 0, 0);
                    }
                    const int t = 16 * tt + fr;
#pragma unroll
                    for (int rg = 0; rg < 4; ++rg) { const int s = 16 * st + 4 * g + rg; const bool keep = dir ? (s >= t) : (s <= t); acc[rg] = keep ? acc[rg] : 0.f; }
                }
                aT[st] = acc;
            }
#pragma unroll
            for (int kk = 0; kk < 2; ++kk) {
                u32x4 aw; aw.x = pk2(aT[2 * kk][0], aT[2 * kk][1]); aw.y = pk2(aT[2 * kk][2], aT[2 * kk][3]);
                aw.z = pk2(aT[2 * kk + 1][0], aT[2 * kk + 1][1]); aw.w = pk2(aT[2 * kk + 1][2], aT[2 * kk + 1][3]);
                const bf16x8 af = as_bf16x8(aw);
#pragma unroll
                for (int nt = 0; nt < 4; ++nt) {
                    const LAS bf16_t* vp = VT + (64 * eh + 16 * nt + fr) * OHG_VP + 32 * kk + 4 * g;
                    const u32x2 lo = *(const LAS u32x2*)(vp), hi = *(const LAS u32x2*)(vp + 16);
                    u32x4 vw; vw.x = lo.x; vw.y = lo.y; vw.z = hi.x; vw.w = hi.y;
                    OI[nt] = __builtin_amdgcn_mfma_f32_16x16x32_bf16(af, as_bf16x8(vw), OI[nt], 0, 0, 0);
                }
            }
        }
        {
            const bf16x8 va0 = *(const LAS bf16x8*)(VT + (16 * w + fr) * OHG_VP + 8 * g), va1 = *(const LAS bf16x8*)(VT + (16 * w + fr) * OHG_VP + 32 + 8 * g);
            bf16_t* up = US + ((size_t)((dir * 8 + b * 4 + h) * 128 + c)) * 16384;
#pragma unroll
            for (int dt = 0; dt < 8; ++dt) {
                const bf16x8 kb0 = *(const LAS bf16x8*)(KPT + (16 * dt + fr) * OHG_VP + 8 * g), kb1 = *(const LAS bf16x8*)(KPT + (16 * dt + fr) * OHG_VP + 32 + 8 * g);
                f32x4 acc = {0.f, 0.f, 0.f, 0.f};
                acc = __builtin_amdgcn_mfma_f32_16x16x32_bf16(va0, kb0, acc, 0, 0, 0);
                acc = __builtin_amdgcn_mfma_f32_16x16x32_bf16(va1, kb1, acc, 0, 0, 0);
                const float dec = DECS[16 * dt + fr];
#pragma unroll
                for (int rg = 0; rg < 4; ++rg) up[(16 * w + 4 * g + rg) * 128 + 16 * dt + fr] = (bf16_t)f2bf(acc[rg] * dec);
            }
        }
#pragma unroll
        for (int i = 0; i < 2; ++i) {
            const int p = tid + i * NTHREADS, s = p >> 4, d8 = (p & 15) * 8;
            *(u32x4*)(H + (tok0 + s) * DIN + zc + h * 128 + d8) = *(const LAS u32x4*)(QT + s * OHG_QP + d8);
        }
        __syncthreads();
    }
#pragma unroll
    for (int nt = 0; nt < 4; ++nt)
#pragma unroll
        for (int rg = 0; rg < 4; ++rg)
            H[(tok0 + 16 * tt + 4 * g + rg) * DIN + C_QH + h * 128 + 64 * eh + 16 * nt + fr] = (bf16_t)f2bf(OI[nt][rg]);
}

#endif
constexpr int HG_QS = 0, HG_VT = 16384, HG_ZQ = 34816, HG_KP = 69632, HG_KPT = 104448, HG_TOT = 141312, HG_DECS = 143360;
constexpr int HG_VP = 72, HG_QP = 136;
constexpr int HG_DIRQ = 64 * HG_QP, HG_DIRT = 128 * HG_VP;
struct HgPre { u32x4 q[2], v[2], zf[2], zb[2]; };
__device__ __forceinline__ void hg_prefetch(HgPre& P, const bf16_t* H, int ht) {
    const int tid = threadIdx.x, b = ht >> 9, h = (ht >> 7) & 3, c = ht & 127;
    const size_t tok0 = (size_t)b * SEQ + (size_t)c * 64;
#pragma unroll
    for (int i = 0; i < 2; ++i) {
        const int p = tid + i * NTHREADS, s = p >> 4, d8 = (p & 15) * 8;
        const bf16_t* rowp = H + (tok0 + s) * DIN + h * 128 + d8;
        P.q[i] = *(const u32x4*)(rowp + C_QH); P.v[i] = *(const u32x4*)(rowp + C_IH); P.zf[i] = *(const u32x4*)(rowp + C_ZF); P.zb[i] = *(const u32x4*)(rowp + C_ZB);
    }
}
template <int DIRV> __device__ __forceinline__ void hg_s1(const LAS bf16_t* ZQd, LAS float* TOTd, float lb, int hf, int d, float (&cum)[32], float (&kk_)[32]) {
    const LAS bf16_t* zp = ZQd + (32 * hf) * HG_QP + d;
    float run = 0.f;
#pragma unroll
    for (int i = 0; i < 32; ++i) {
        const float z = bf2f(zp[(DIRV ? (31 - i) : i) * HG_QP]);
        const float ez = __expf(-z), sg = __builtin_amdgcn_rcpf(1.f + ez);
        const float f = lb + (1.f - lb) * sg;
        run += __logf(f); cum[i] = run; kk_[i] = (1.f - lb) * (1.f - sg);
    }
    TOTd[hf * 128 + d] = run;
}
template <int DIRV> __device__ __forceinline__ void hg_s2(const LAS bf16_t* QS, LAS bf16_t* ZQd, LAS bf16_t* KPd, LAS bf16_t* KPTd, float pre, int hf, int d, const float (&cum)[32], const float (&kk_)[32]) {
    const LAS bf16_t* qp = QS + (32 * hf) * 128 + d;
    LAS bf16_t* zq = ZQd + (32 * hf) * HG_QP + d; LAS bf16_t* kp = KPd + (32 * hf) * HG_QP + d; LAS bf16_t* kt = KPTd + d * HG_VP + 32 * hf;
#pragma unroll
    for (int i = 0; i < 32; i += 2) {
        const int sA = DIRV ? (31 - i) : i, sB = DIRV ? (sA - 1) : (sA + 1);
        const float bA = cum[i] + pre, bB = cum[i + 1] + pre;
        const float qA = bf2f(qp[sA * 128]), qB = bf2f(qp[sB * 128]);
        const unsigned qtA = f2bf(qA * __expf(bA)), qtB = f2bf(qB * __expf(bB));
        const unsigned kpA = f2bf(kk_[i] * __expf(-bA)), kpB = f2bf(kk_[i + 1] * __expf(-bB));
        zq[sA * HG_QP] = (bf16_t)qtA; zq[sB * HG_QP] = (bf16_t)qtB;
        kp[sA * HG_QP] = (bf16_t)kpA; kp[sB * HG_QP] = (bf16_t)kpB;
        *(LAS unsigned*)(kt + (DIRV ? sB : sA)) = DIRV ? (kpB | (kpA << 16)) : (kpA | (kpB << 16));
    }
}
__device__ __forceinline__ void hgrn_local_phase(LAS unsigned char* lds, bf16_t* H, const float* lbf, const float* lbb, bf16_t* US, float* DEC, int bx, int G) {
    const int tid = threadIdx.x, lane = tid & 63, w = tid >> 6, fr = lane & 15, g = lane >> 4;
    LAS bf16_t* QS = (LAS bf16_t*)(lds + HG_QS); LAS bf16_t* VT = (LAS bf16_t*)(lds + HG_VT); LAS bf16_t* ZQ = (LAS bf16_t*)(lds + HG_ZQ);
    LAS bf16_t* KP = (LAS bf16_t*)(lds + HG_KP); LAS bf16_t* KPT = (LAS bf16_t*)(lds + HG_KPT); LAS float* TOT = (LAS float*)(lds + HG_TOT); LAS float* DECS = (LAS float*)(lds + HG_DECS);
    if (bx >= 1024) return;
    HgPre P; hg_prefetch(P, H, bx);
    const int d = tid & 127, hf = (tid >> 7) & 1, edir = tid >> 8;
    for (int ht = bx; ht < 1024; ht += G) {
        const int b = ht >> 9, h = (ht >> 7) & 3, c = ht & 127;
        const size_t tok0 = (size_t)b * SEQ + (size_t)c * 64;
#ifdef HG_NOPF
        if (ht != bx) hg_prefetch(P, H, ht);
#endif
#pragma unroll
        for (int i = 0; i < 2; ++i) {
            const int p = tid + i * NTHREADS, s = p >> 4, d8 = (p & 15) * 8;
            *(LAS u32x4*)(QS + s * 128 + d8) = P.q[i];
            *(LAS u32x4*)(ZQ + s * HG_QP + d8) = P.zf[i];
            *(LAS u32x4*)(ZQ + HG_DIRQ + s * HG_QP + d8) = P.zb[i];
#pragma unroll
            for (int k = 0; k < 4; ++k) { VT[(d8 + 2 * k) * HG_VP + s] = (bf16_t)(P.v[i][k] & 0xffffu); VT[(d8 + 2 * k + 1) * HG_VP + s] = (bf16_t)(P.v[i][k] >> 16); }
        }
        __syncthreads();
#ifndef HG_NOPF
        if (ht + G < 1024) hg_prefetch(P, H, ht + G);
#endif
        const float* lbl = edir ? lbb : lbf;
        const float lb = 1.f / (1.f + __expf(lbl[512 + h * 128 + d] - lbl[h * 128 + d]));
        float cum[32], kk_[32];
        if (edir == 0) hg_s1<0>(ZQ, TOT, lb, hf, d, cum, kk_); else hg_s1<1>(ZQ + HG_DIRQ, TOT + 256, lb, hf, d, cum, kk_);
        __syncthreads();
        {
            const float t0 = TOT[(edir * 2) * 128 + d], t1 = TOT[(edir * 2 + 1) * 128 + d];
            const float pre = edir ? (hf ? 0.f : t1) : (hf ? t0 : 0.f);
            if (hf == 0) { const float dec = __expf(t0 + t1); DECS[edir * 128 + d] = dec; DEC[((size_t)((edir * 8 + b * 4 + h) * 128 + c)) * 128 + d] = dec; }
            if (edir == 0) hg_s2<0>(QS, ZQ, KP, KPT, pre, hf, d, cum, kk_); else hg_s2<1>(QS, ZQ + HG_DIRQ, KP + HG_DIRQ, KPT + HG_DIRT, pre, hf, d, cum, kk_);
        }
        __syncthreads();
#ifdef HG_OLDS3
        {
            const int tt = w & 3, eh = w >> 2;
            f32x4 OI[4];
#pragma unroll
            for (int nt = 0; nt < 4; ++nt) OI[nt] = (f32x4){0.f, 0.f, 0.f, 0.f};
#pragma unroll
            for (int dir = 0; dir < 2; ++dir) {
                const LAS bf16_t* QTd = ZQ + dir * HG_DIRQ; const LAS bf16_t* KPd = KP + dir * HG_DIRQ; const LAS bf16_t* KPTd = KPT + dir * HG_DIRT;
                f32x4 aT[4];
#pragma unroll
                for (int st = 0; st < 4; ++st) {
                    f32x4 acc = {0.f, 0.f, 0.f, 0.f};
                    const bool live = dir ? (st >= tt) : (st <= tt);
                    if (live) {
#pragma unroll
                        for (int ks = 0; ks < 4; ++ks) {
                            const bf16x8 af = *(const LAS bf16x8*)(KPd + (16 * st + fr) * HG_QP + 32 * ks + 8 * g);
                            const bf16x8 bfr = *(const LAS bf16x8*)(QTd + (16 * tt + fr) * HG_QP + 32 * ks + 8 * g);
                            acc = __builtin_amdgcn_mfma_f32_16x16x32_bf16(af, bfr, acc, 0, 0, 0);
                        }
                        const int t = 16 * tt + fr;
#pragma unroll
                        for (int rg = 0; rg < 4; ++rg) { const int s = 16 * st + 4 * g + rg; const bool keep = dir ? (s >= t) : (s <= t); acc[rg] = keep ? acc[rg] : 0.f; }
                    }
                    aT[st] = acc;
                }
#pragma unroll
                for (int kk = 0; kk < 2; ++kk) {
                    u32x4 aw; aw.x = pk2(aT[2 * kk][0], aT[2 * kk][1]); aw.y = pk2(aT[2 * kk][2], aT[2 * kk][3]);
                    aw.z = pk2(aT[2 * kk + 1][0], aT[2 * kk + 1][1]); aw.w = pk2(aT[2 * kk + 1][2], aT[2 * kk + 1][3]);
                    const bf16x8 af = as_bf16x8(aw);
#pragma unroll
                    for (int nt = 0; nt < 4; ++nt) {
                        const LAS bf16_t* vp = VT + (64 * eh + 16 * nt + fr) * HG_VP + 32 * kk + 4 * g;
                        const u32x2 lo = *(const LAS u32x2*)(vp), hi = *(const LAS u32x2*)(vp + 16);
                        u32x4 vw; vw.x = lo.x; vw.y = lo.y; vw.z = hi.x; vw.w = hi.y;
                        OI[nt] = __builtin_amdgcn_mfma_f32_16x16x32_bf16(af, as_bf16x8(vw), OI[nt], 0, 0, 0);
                    }
                }
#ifndef HG_NEWS3B
                {
                    const bf16x8 va0 = *(const LAS bf16x8*)(VT + (16 * w + fr) * HG_VP + 8 * g), va1 = *(const LAS bf16x8*)(VT + (16 * w + fr) * HG_VP + 32 + 8 * g);
                    bf16_t* up = US + ((size_t)((dir * 8 + b * 4 + h) * 128 + c)) * 16384;
#pragma unroll
                    for (int dt = 0; dt < 8; ++dt) {
                        const bf16x8 kb0 = *(const LAS bf16x8*)(KPTd + (16 * dt + fr) * HG_VP + 8 * g), kb1 = *(const LAS bf16x8*)(KPTd + (16 * dt + fr) * HG_VP + 32 + 8 * g);
                        f32x4 acc = {0.f, 0.f, 0.f, 0.f};
                        acc = __builtin_amdgcn_mfma_f32_16x16x32_bf16(va0, kb0, acc, 0, 0, 0);
                        acc = __builtin_amdgcn_mfma_f32_16x16x32_bf16(va1, kb1, acc, 0, 0, 0);
                        const float dec = DECS[dir * 128 + 16 * dt + fr];
#pragma unroll
                        for (int rg = 0; rg < 4; ++rg) up[(16 * w + 4 * g + rg) * 128 + 16 * dt + fr] = (bf16_t)f2bf(acc[rg] * dec);
                    }
                }
#endif
            }
#pragma unroll
            for (int nt = 0; nt < 4; ++nt)
#pragma unroll
                for (int rg = 0; rg < 4; ++rg)
                    H[(tok0 + 16 * tt + 4 * g + rg) * DIN + C_QH + h * 128 + 64 * eh + 16 * nt + fr] = (bf16_t)f2bf(OI[nt][rg]);
        }
#ifdef HG_NEWS3B
        {
            const int dir = w >> 2, ep = w & 3;
            bf16x8 vb[2][2];
#pragma unroll
            for (int j = 0; j < 2; ++j)
#pragma unroll
                for (int ks = 0; ks < 2; ++ks) vb[j][ks] = *(const LAS bf16x8*)(VT + (32 * ep + 16 * j + fr) * HG_VP + 32 * ks + 8 * g);
            bf16_t* up = US + ((size_t)((dir * 8 + b * 4 + h) * 128 + c)) * 16384;
#pragma unroll
            for (int dt = 0; dt < 8; ++dt) {
                const bf16x8 ka0 = *(const LAS bf16x8*)(KPT + dir * HG_DIRT + (16 * dt + fr) * HG_VP + 8 * g), ka1 = *(const LAS bf16x8*)(KPT + dir * HG_DIRT + (16 * dt + fr) * HG_VP + 32 + 8 * g);
                const f32x4 dec = *(const LAS f32x4*)(DECS + dir * 128 + 16 * dt + 4 * g);
#pragma unroll
                for (int j = 0; j < 2; ++j) {
                    f32x4 acc = {0.f, 0.f, 0.f, 0.f};
                    acc = __builtin_amdgcn_mfma_f32_16x16x32_bf16(ka0, vb[j][0], acc, 0, 0, 0);
                    acc = __builtin_amdgcn_mfma_f32_16x16x32_bf16(ka1, vb[j][1], acc, 0, 0, 0);
                    acc = acc * dec;
                    u32x2 ow; ow.x = pk2(acc[0], acc[1]); ow.y = pk2(acc[2], acc[3]);
                    *(u32x2*)(up + (32 * ep + 16 * j + fr) * 128 + 16 * dt + 4 * g) = ow;
                }
            }
        }
#endif
#else
        {
            const int tt = w & 3, eh = w >> 2;
            f32x4 OI[4];
#pragma unroll
            for (int et = 0; et < 4; ++et) OI[et] = (f32x4){0.f, 0.f, 0.f, 0.f};
#pragma unroll
            for (int dir = 0; dir < 2; ++dir) {
                f32x4 aT[4];
#pragma unroll
                for (int st = 0; st < 4; ++st) {
                    f32x4 acc = {0.f, 0.f, 0.f, 0.f};
                    const bool live = dir ? (st >= tt) : (st <= tt);
                    if (live) {
#pragma unroll
                        for (int ks = 0; ks < 4; ++ks) {
                            const bf16x8 af = *(const LAS bf16x8*)(KP + dir * HG_DIRQ + (16 * st + fr) * HG_QP + 32 * ks + 8 * g);
                            const bf16x8 bfr = *(const LAS bf16x8*)(ZQ + dir * HG_DIRQ + (16 * tt + fr) * HG_QP + 32 * ks + 8 * g);
                            acc = __builtin_amdgcn_mfma_f32_16x16x32_bf16(af, bfr, acc, 0, 0, 0);
                        }
                        const int t = 16 * tt + fr;
#pragma unroll
                        for (int rg = 0; rg < 4; ++rg) { const int s = 16 * st + 4 * g + rg; const bool keep = dir ? (s >= t) : (s <= t); acc[rg] = keep ? acc[rg] : 0.f; }
                    }
                    aT[st] = acc;
                }
#pragma unroll
                for (int kk = 0; kk < 2; ++kk) {
                    u32x4 aw; aw.x = pk2(aT[2 * kk][0], aT[2 * kk][1]); aw.y = pk2(aT[2 * kk][2], aT[2 * kk][3]);
                    aw.z = pk2(aT[2 * kk + 1][0], aT[2 * kk + 1][1]); aw.w = pk2(aT[2 * kk + 1][2], aT[2 * kk + 1][3]);
                    const bf16x8 pb = as_bf16x8(aw);
#pragma unroll
                    for (int et = 0; et < 4; ++et) {
                        const LAS bf16_t* vp = VT + (64 * eh + 16 * et + fr) * HG_VP + 32 * kk + 4 * g;
                        const u32x2 lo = *(const LAS u32x2*)(vp), hi = *(const LAS u32x2*)(vp + 16);
                        u32x4 vw; vw.x = lo.x; vw.y = lo.y; vw.z = hi.x; vw.w = hi.y;
                        OI[et] = __builtin_amdgcn_mfma_f32_16x16x32_bf16(as_bf16x8(vw), pb, OI[et], 0, 0, 0);
                    }
                }
            }
#pragma unroll
            for (int et = 0; et < 4; ++et) {
                u32x2 ow; ow.x = pk2(OI[et][0], OI[et][1]); ow.y = pk2(OI[et][2], OI[et][3]);
                *(u32x2*)(H + (tok0 + 16 * tt + fr) * DIN + C_QH + h * 128 + 64 * eh + 16 * et + 4 * g) = ow;
            }
        }
        {
            const int dir = w >> 2, ep = w & 3;
            bf16x8 vb[2][2];
#pragma unroll
            for (int j = 0; j < 2; ++j)
#pragma unroll
                for (int ks = 0; ks < 2; ++ks) vb[j][ks] = *(const LAS bf16x8*)(VT + (32 * ep + 16 * j + fr) * HG_VP + 32 * ks + 8 * g);
            bf16_t* up = US + ((size_t)((dir * 8 + b * 4 + h) * 128 + c)) * 16384;
#pragma unroll
            for (int dt = 0; dt < 8; ++dt) {
                const bf16x8 ka0 = *(const LAS bf16x8*)(KPT + dir * HG_DIRT + (16 * dt + fr) * HG_VP + 8 * g), ka1 = *(const LAS bf16x8*)(KPT + dir * HG_DIRT + (16 * dt + fr) * HG_VP + 32 + 8 * g);
                const f32x4 dec = *(const LAS f32x4*)(DECS + dir * 128 + 16 * dt + 4 * g);
#pragma unroll
                for (int j = 0; j < 2; ++j) {
                    f32x4 acc = {0.f, 0.f, 0.f, 0.f};
                    acc = __builtin_amdgcn_mfma_f32_16x16x32_bf16(ka0, vb[j][0], acc, 0, 0, 0);
                    acc = __builtin_amdgcn_mfma_f32_16x16x32_bf16(ka1, vb[j][1], acc, 0, 0, 0);
                    acc = acc * dec;
                    u32x2 ow; ow.x = pk2(acc[0], acc[1]); ow.y = pk2(acc[2], acc[3]);
                    *(u32x2*)(up + (32 * ep + 16 * j + fr) * 128 + 16 * dt + 4 * g) = ow;
                }
            }
        }
#endif
#pragma unroll
        for (int i = 0; i < 4; ++i) {
            const int p = tid + i * NTHREADS, dir = p >> 10, pp = p & 1023, s = pp >> 4, d8 = (pp & 15) * 8;
            *(u32x4*)(H + (tok0 + s) * DIN + (dir ? C_ZB : C_ZF) + h * 128 + d8) = *(const LAS u32x4*)(ZQ + dir * HG_DIRQ + s * HG_QP + d8);
        }
        __syncthreads();
    }
}

__device__ __forceinline__ void hgrn_state_scan(bf16_t* US, const float* DEC, int dry) {
    if (threadIdx.x >= 256) return;
    const int gt = blockIdx.x * 256 + threadIdx.x, GT = gridDim.x * 256;
    for (int it = gt; it < 16 * 4096; it += GT) {
        const int sidx = it >> 12, rem = (it & 4095) * 4, d = rem & 127, dir = sidx >> 3;
        f32x4 st = {0.f, 0.f, 0.f, 0.f};
        for (int c0 = 0; c0 < 128; c0 += 8) {
            u32x2 u[8]; f32x4 dc[8];
#pragma unroll
            for (int k = 0; k < 8; ++k) {
                const int c = dir ? (127 - c0 - k) : (c0 + k);
                u[k] = *(const u32x2*)(US + ((size_t)(sidx * 128 + c)) * 16384 + rem);
                dc[k] = *(const f32x4*)(DEC + ((size_t)(sidx * 128 + c)) * 128 + d);
            }
#pragma unroll
            for (int k = 0; k < 8; ++k) {
                const int c = dir ? (127 - c0 - k) : (c0 + k);
                u32x2 o; o.x = pk2(st[0], st[1]); o.y = pk2(st[2], st[3]);
                *(u32x2*)(US + ((size_t)(sidx * 128 + c)) * 16384 + rem) = dry ? u[k] : o;
                const f32x4 uv = {bf2f(u[k].x & 0xffffu), bf2f(u[k].x >> 16), bf2f(u[k].y & 0xffffu), bf2f(u[k].y >> 16)};
                st = dc[k] * st + uv;
            }
        }
    }
}

__device__ __forceinline__ void hgrn_out_phase(const bf16_t* H, const bf16_t* US, const float* gain, bf16_t* CAT, int bx, int G) {
    const int tid = threadIdx.x, lane = tid & 63, w = tid >> 6, fr = lane & 15, g = lane >> 4;
    for (int item = bx * 8 + w; item < 2048; item += G * 8) {
        const int ht = item >> 1, tp = item & 1;
        const int b = ht >> 9, h = (ht >> 7) & 3, c = ht & 127;
        const size_t tok0 = (size_t)b * SEQ + (size_t)c * 64 + 32 * tp;
        f32x4 acc[2][8];
#pragma unroll
        for (int j = 0; j < 2; ++j)
#pragma unroll
            for (int et = 0; et < 8; ++et) acc[j][et] = (f32x4){0.f, 0.f, 0.f, 0.f};
        {
            const bf16_t* sp0 = US + ((size_t)((0 * 8 + b * 4 + h) * 128 + c)) * 16384 + 8 * g + fr * 128;
            const bf16_t* sp1 = US + ((size_t)((1 * 8 + b * 4 + h) * 128 + c)) * 16384 + 8 * g + fr * 128;
            const bf16_t* qp = H + (tok0 + fr) * DIN + h * 128 + 8 * g;
            bf16x8 qb[2][4], cur[8], nxt[8];
#pragma unroll
            for (int j = 0; j < 2; ++j)
#pragma unroll
                for (int ks = 0; ks < 4; ++ks) qb[j][ks] = as_bf16x8(*(const u32x4*)(qp + (size_t)(16 * j) * DIN + C_ZF + 32 * ks));
#pragma unroll
            for (int i = 0; i < 8; ++i) cur[i] = as_bf16x8(*(const u32x4*)(sp0 + (16 * (i >> 2)) * 128 + 32 * (i & 3)));
#pragma unroll
            for (int p = 0; p < 8; ++p) {
                const int et2 = p & 3;
                if (p + 1 < 8) { const bf16_t* spn = ((p + 1) >> 2) ? sp1 : sp0; const int e2n = (p + 1) & 3;
#pragma unroll
                    for (int i = 0; i < 8; ++i) nxt[i] = as_bf16x8(*(const u32x4*)(spn + (16 * (2 * e2n + (i >> 2))) * 128 + 32 * (i & 3))); }
#pragma unroll
                for (int e = 0; e < 2; ++e)
#pragma unroll
                    for (int ks = 0; ks < 4; ++ks) {
                        acc[0][2 * et2 + e] = __builtin_amdgcn_mfma_f32_16x16x32_bf16(cur[e * 4 + ks], qb[0][ks], acc[0][2 * et2 + e], 0, 0, 0);
                        acc[1][2 * et2 + e] = __builtin_amdgcn_mfma_f32_16x16x32_bf16(cur[e * 4 + ks], qb[1][ks], acc[1][2 * et2 + e], 0, 0, 0);
                    }
                if (p == 3) {
#pragma unroll
                    for (int j = 0; j < 2; ++j)
#pragma unroll
                        for (int ks = 0; ks < 4; ++ks) qb[j][ks] = as_bf16x8(*(const u32x4*)(qp + (size_t)(16 * j) * DIN + C_ZB + 32 * ks));
                }
                __builtin_amdgcn_sched_barrier(0);
#pragma unroll
                for (int i = 0; i < 8; ++i) cur[i] = nxt[i];
            }
        }
#pragma unroll
        for (int j = 0; j < 2; ++j) {
            const bf16_t* hrow = H + (tok0 + 16 * j + fr) * DIN + h * 128 + 4 * g;
            float ssq = 0.f;
#pragma unroll
            for (int et = 0; et < 8; ++et) {
                const u32x2 oi = *(const u32x2*)(hrow + C_QH + 16 * et);
                acc[j][et][0] += bf2f(oi.x & 0xffffu); acc[j][et][1] += bf2f(oi.x >> 16); acc[j][et][2] += bf2f(oi.y & 0xffffu); acc[j][et][3] += bf2f(oi.y >> 16);
                ssq += acc[j][et][0] * acc[j][et][0] + acc[j][et][1] * acc[j][et][1] + acc[j][et][2] * acc[j][et][2] + acc[j][et][3] * acc[j][et][3];
            }
            ssq += __shfl_xor(ssq, 16); ssq += __shfl_xor(ssq, 32);
            const float rsn = rsqrtf(ssq * (1.f / 128.f) + 1e-6f);
#pragma unroll
            for (int et = 0; et < 8; ++et) {
                const u32x2 gw = *(const u32x2*)(hrow + C_GH + 16 * et);
                const f32x4 gn = *(const f32x4*)(gain + h * 128 + 16 * et + 4 * g);
                const float g0 = bf2f(gw.x & 0xffffu), g1 = bf2f(gw.x >> 16), g2 = bf2f(gw.y & 0xffffu), g3 = bf2f(gw.y >> 16);
                u32x2 ow; ow.x = pk2(acc[j][et][0] * rsn * gn[0] * siluf_(g0), acc[j][et][1] * rsn * gn[1] * siluf_(g1));
                ow.y = pk2(acc[j][et][2] * rsn * gn[2] * siluf_(g2), acc[j][et][3] * rsn * gn[3] * siluf_(g3));
                *(u32x2*)(CAT + (tok0 + 16 * j + fr) * DM + 512 + h * 128 + 16 * et + 4 * g) = ow;
            }
        }
    }
}

#ifdef OLD_P4
__device__ __forceinline__ void hgrn_out_tile(LAS unsigned char* lds, const bf16_t* H, const bf16_t* US, const float* gain, bf16_t* CAT, int ht) {
    const int tid = threadIdx.x, lane = tid & 63, w = tid >> 6, fr = lane & 15, g = lane >> 4;
    const int b = ht >> 9, h = (ht >> 7) & 3, c = ht & 127;
    const size_t tok0 = (size_t)b * SEQ + (size_t)c * 64;
    const int tt = w & 3, eh = w >> 2;
    LAS float* SSQ = (LAS float*)lds;
    f32x4 acc[4];
#pragma unroll
    for (int nt = 0; nt < 4; ++nt) acc[nt] = (f32x4){0.f, 0.f, 0.f, 0.f};
#pragma unroll
    for (int dir = 0; dir < 2; ++dir) {
        const bf16_t* qp = H + (tok0 + 16 * tt + fr) * DIN + (dir ? C_ZB : C_ZF) + h * 128 + 8 * g;
        const bf16_t* sp = US + ((size_t)((dir * 8 + b * 4 + h) * 128 + c)) * 16384 + 8 * g;
        bf16x8 qa[4];
#pragma unroll
        for (int ks = 0; ks < 4; ++ks) qa[ks] = as_bf16x8(*(const u32x4*)(qp + 32 * ks));
#pragma unroll
        for (int nt = 0; nt < 4; ++nt)
#pragma unroll
            for (int ks = 0; ks < 4; ++ks) {
                const bf16x8 sb = as_bf16x8(*(const u32x4*)(sp + (64 * eh + 16 * nt + fr) * 128 + 32 * ks));
                acc[nt] = __builtin_amdgcn_mfma_f32_16x16x32_bf16(qa[ks], sb, acc[nt], 0, 0, 0);
            }
    }
    float ssq[4] = {0.f, 0.f, 0.f, 0.f};
#pragma unroll
    for (int nt = 0; nt < 4; ++nt)
#pragma unroll
        for (int rg = 0; rg < 4; ++rg) {
            acc[nt][rg] += bf2f(H[(tok0 + 16 * tt + 4 * g + rg) * DIN + C_QH + h * 128 + 64 * eh + 16 * nt + fr]);
            ssq[rg] += acc[nt][rg] * acc[nt][rg];
        }
#pragma unroll
    for (int rg = 0; rg < 4; ++rg) {
        float v = ssq[rg];
        v += __shfl_xor(v, 1); v += __shfl_xor(v, 2); v += __shfl_xor(v, 4); v += __shfl_xor(v, 8);
        ssq[rg] = v;
    }
    if (fr == 0) {
#pragma unroll
        for (int rg = 0; rg < 4; ++rg) SSQ[eh * 64 + 16 * tt + 4 * g + rg] = ssq[rg];
    }
    __syncthreads();
#pragma unroll
    for (int rg = 0; rg < 4; ++rg) {
        const int t = 16 * tt + 4 * g + rg;
        const float rsn = rsqrtf((SSQ[t] + SSQ[64 + t]) * (1.f / 128.f) + 1e-6f);
#pragma unroll
        for (int nt = 0; nt < 4; ++nt) {
            const int e = h * 128 + 64 * eh + 16 * nt + fr;
            const float gh = bf2f(H[(tok0 + t) * DIN + C_GH + e]);
            CAT[(tok0 + t) * DM + 512 + e] = (bf16_t)f2bf(acc[nt][rg] * rsn * gain[e] * siluf_(gh));
        }
    }
    __syncthreads();
}

#endif
#ifdef OLD_P3
__device__ __forceinline__ void hgrn_state_scan_old(bf16_t* US, const float* DEC, int dry) {
    const int gt = blockIdx.x * NTHREADS + threadIdx.x, GT = gridDim.x * NTHREADS;
    for (int it = gt; it < 16 * 8192; it += GT) {
        const int sidx = it >> 13, rem = (it & 8191) * 2, d = rem & 127, dir = sidx >> 3;
        float s0 = 0.f, s1 = 0.f;
        for (int c0 = 0; c0 < 128; c0 += 8) {
            unsigned u[8]; float2 dc[8];
#pragma unroll
            for (int k = 0; k < 8; ++k) {
                const int c = dir ? (127 - c0 - k) : (c0 + k);
                u[k] = *(const unsigned*)(US + ((size_t)(sidx * 128 + c)) * 16384 + rem);
                dc[k] = *(const float2*)(DEC + ((size_t)(sidx * 128 + c)) * 128 + d);
            }
#pragma unroll
            for (int k = 0; k < 8; ++k) {
                const int c = dir ? (127 - c0 - k) : (c0 + k);
                *(unsigned*)(US + ((size_t)(sidx * 128 + c)) * 16384 + rem) = dry ? u[k] : pk2(s0, s1);
                s0 = dc[k].x * s0 + bf2f(u[k] & 0xffffu); s1 = dc[k].y * s1 + bf2f(u[k] >> 16);
            }
        }
    }
}

#endif
__device__ __forceinline__ void ln_rows(const float* R, const float* gain, const float* bias, float* out) {
    const int lane = threadIdx.x & 63, gw = blockIdx.x * 8 + (threadIdx.x >> 6), GW = gridDim.x * 8;
    f32x4 gv[4], bv[4];
#pragma unroll
    for (int i = 0; i < 4; ++i) { gv[i] = *(const f32x4*)(gain + i * 256 + lane * 4); bv[i] = *(const f32x4*)(bias + i * 256 + lane * 4); }
    for (int row0 = gw * 4; row0 < MROWS; row0 += GW * 4) {
        f32x4 v[4][4]; float s[4], q[4];
#pragma unroll
        for (int r = 0; r < 4; ++r)
#pragma unroll
            for (int i = 0; i < 4; ++i) v[r][i] = *(const f32x4*)(R + (size_t)(row0 + r) * DM + i * 256 + lane * 4);
#pragma unroll
        for (int r = 0; r < 4; ++r) { s[r] = 0.f;
#pragma unroll
            for (int i = 0; i < 4; ++i) s[r] += v[r][i][0] + v[r][i][1] + v[r][i][2] + v[r][i][3]; }
#pragma unroll
        for (int o = 1; o < 64; o <<= 1)
#pragma unroll
            for (int r = 0; r < 4; ++r) s[r] += __shfl_xor(s[r], o);
#pragma unroll
        for (int r = 0; r < 4; ++r) { const float mu = s[r] * (1.f / 1024.f); q[r] = 0.f;
#pragma unroll
            for (int i = 0; i < 4; ++i) { v[r][i] = v[r][i] - mu; q[r] += v[r][i][0] * v[r][i][0] + v[r][i][1] * v[r][i][1] + v[r][i][2] * v[r][i][2] + v[r][i][3] * v[r][i][3]; } }
#pragma unroll
        for (int o = 1; o < 64; o <<= 1)
#pragma unroll
            for (int r = 0; r < 4; ++r) q[r] += __shfl_xor(q[r], o);
#pragma unroll
        for (int r = 0; r < 4; ++r) { const float rsd = rsqrtf(q[r] * (1.f / 1024.f) + 1e-5f);
#pragma unroll
            for (int i = 0; i < 4; ++i) __builtin_nontemporal_store(v[r][i] * rsd * gv[i] + bv[i], (f32x4*)(out + (size_t)(row0 + r) * DM + i * 256 + lane * 4)); }
    }
}

#define XB_TMO      128
#define XB_XCNT(j)  (256  + 64 * (j))
#define XB_XSUB(j)  (1280 + 64 * (j))
#define XB_XGEN(j)  (2304 + 64 * (j))
#define XB_TOP      3328
#define XB_TOPGEN   3392
#define XCD_BAR_WORDS 3456
#define XB_SPIN_CAP (1u << 18)
__device__ __forceinline__ unsigned xb_ld(unsigned* p)              { return __hip_atomic_load(p, __ATOMIC_RELAXED, __HIP_MEMORY_SCOPE_AGENT); }
__device__ __forceinline__ unsigned xb_add(unsigned* p, unsigned v) { return __hip_atomic_fetch_add(p, v, __ATOMIC_RELAXED, __HIP_MEMORY_SCOPE_AGENT); }
__device__ __forceinline__ unsigned xb_xcc_id() { return (unsigned)__builtin_amdgcn_s_getreg((3 << 11) | 20) & 0xFu; }
#define XB_SPIN(cond, bar) do { unsigned _sp = 0; while (cond) { __builtin_amdgcn_s_sleep(1); \
    if ((++_sp & 255u) == 0u) { if (xb_ld(&(bar)[XB_TMO])) break; if (_sp > XB_SPIN_CAP) { atomicAdd(&(bar)[XB_TMO], 1u); break; } } } } while (0)
struct XcdBarrier { unsigned* bar; unsigned x; volatile LAS unsigned* st; };
__device__ __forceinline__ XcdBarrier xcd_barrier_post(unsigned* bar, volatile LAS unsigned* st) {
    XcdBarrier b; b.bar = bar; b.x = xb_xcc_id(); b.st = st;
    if (threadIdx.x == 0) (void)xb_add(&bar[XB_XCNT(b.x)], 1u);
    return b;
}
__device__ __forceinline__ void xcd_barrier_complete(unsigned* bar, unsigned x, unsigned& nloc, unsigned& nx) {
    const unsigned G = gridDim.x * gridDim.y * gridDim.z;
    unsigned sum, cnt, mine, sp = 0u;
    for (;;) {
        sum = 0u; cnt = 0u; mine = 0u;
#pragma unroll
        for (unsigned j = 0; j < 16; ++j) { const unsigned c = xb_ld(&bar[XB_XCNT(j)]); sum += c; cnt += (c > 0u) ? 1u : 0u; mine = (j == x) ? c : mine; }
        if (sum == G) break;
        __builtin_amdgcn_s_sleep(1);
        if ((++sp & 255u) == 0u) { if (xb_ld(&bar[XB_TMO])) break; if (sp > XB_SPIN_CAP) { atomicAdd(&bar[XB_TMO], 1u); break; } }
    }
    nloc = mine > 0u ? mine : 1u; nx = cnt > 0u ? cnt : 1u;
}
__device__ __forceinline__ void xcd_barrier(const XcdBarrier& b) {
    asm volatile("s_waitcnt vmcnt(0)" ::: "memory");
    __syncthreads();
    if (threadIdx.x == 0) {
        unsigned* bar = b.bar;
        __builtin_amdgcn_s_waitcnt(0);
        unsigned nloc = b.st[0], nx = b.st[1];
        if (nloc == 0u) { xcd_barrier_complete(bar, b.x, nloc, nx); b.st[0] = nloc; b.st[1] = nx; }
        const unsigned old = xb_add(&bar[XB_XSUB(b.x)], 1u);
        const unsigned gen = old / nloc;
        if (old + 1u == (gen + 1u) * nloc) {
            __builtin_amdgcn_fence(__ATOMIC_RELEASE, "agent");
            asm volatile("s_waitcnt vmcnt(0)" ::: "memory");
            const unsigned og = xb_add(&bar[XB_TOP], 1u);
            const unsigned tg = og / nx;
            if (og + 1u == (tg + 1u) * nx) xb_add(&bar[XB_TOPGEN], 1u);
            else XB_SPIN(xb_ld(&bar[XB_TOPGEN]) == tg, bar);
            __builtin_amdgcn_fence(__ATOMIC_ACQUIRE, "agent");
            xb_add(&bar[XB_XGEN(b.x)], 1u);
            asm volatile("s_waitcnt vmcnt(0)" ::: "memory");
        } else {
            XB_SPIN(xb_ld(&bar[XB_XGEN(b.x)]) == gen, bar);
            __builtin_amdgcn_fence(__ATOMIC_ACQUIRE, "agent");
            asm volatile("s_waitcnt vmcnt(0)" ::: "memory");
        }
    }
    __syncthreads();
}

__global__ void __launch_bounds__(NTHREADS, 2) fwd_kernel(Args args) {
    extern __shared__ __attribute__((aligned(16))) unsigned char lds_raw[];
    LAS unsigned char* lds = (LAS unsigned char*)lds_raw;
    unsigned char* ws = args.ws;
    bf16_t* US = (bf16_t*)(ws + WS_US); bf16_t* XB = (bf16_t*)(ws + WS_US); float* R = (float*)(ws + WS_US);
    bf16_t* WIN = (bf16_t*)(ws + WS_WIN); bf16_t* WOUT = (bf16_t*)(ws + WS_WOUT); float* DEC = (float*)(ws + WS_DEC);
    bf16_t* H = (bf16_t*)(ws + WS_H); bf16_t* CAT = (bf16_t*)(ws + WS_CAT);
    const float* x = args.in[0]; const float* w_in = args.in[1]; const float* b_in = args.in[2]; const float* rpb = args.in[3];
    const float* lbf = args.in[4]; const float* lbb = args.in[5]; const float* hgain = args.in[6]; const float* w_out = args.in[7];
    const float* b_out = args.in[8]; const float* ln_g = args.in[9]; const float* ln_b = args.in[10];
    const int G = gridDim.x, bx = blockIdx.x;
    const int vcu = (G % 8 == 0) ? (bx % 8) * (G / 8) + bx / 8 : bx;
    const int lo = args.ph_lo, hi = args.ph_hi;
#define IN(k) (lo <= (k) && (k) < hi)
    volatile LAS unsigned* bst = (volatile LAS unsigned*)(lds + LDS_BYTES - 64);
    if (threadIdx.x == 0) { bst[0] = 0u; bst[1] = 0u; }
    __syncthreads();
    XcdBarrier bar; bar.bar = (unsigned*)(ws + WS_CTL); bar.x = 0; bar.st = bst;
    if (args.coop) bar = xcd_barrier_post((unsigned*)(ws + WS_CTL), bst);
#define SEAM(k) do { if (args.coop && IN(k) && IN((k) + 1)) xcd_barrier(bar); } while (0)
    if (IN(0)) p0_convert(x, w_in, w_out, XB, WIN, WOUT);
    SEAM(0);
    if (IN(1)) {
        pg8::Gemm gm{XB, WIN, MROWS, DIN, DM}; pg8::StaticOrder so; so.init(MROWS, DIN, G, vcu);
        EpiH ep{H, b_in};
        pg8::gemm_phase<EpiH, pg8::StaticOrder, true, true>(lds, gm, so, ep);
    }
    SEAM(1);
    if (IN(2)) {
        for (int at = bx; at < 1024; at += G) { const int a2 = (at % 256) * 4 + at / 256; attn_tile(lds, H, rpb, CAT, a2); }
#ifndef NO_HG
#ifdef OLD_P2B
        if (args.pad == 0) for (int ht = bx; ht < 1024; ht += G) hgrn_local_tile(lds, H, lbf, lbb, US, DEC, ht);
#else
        if (args.pad == 0) hgrn_local_phase(lds, H, lbf, lbb, US, DEC, bx, G);
#endif
#endif
    }
    SEAM(2);
#ifdef OLD_P3
    if (IN(3)) hgrn_state_scan_old(US, DEC, args.pad);
#else
    if (IN(3)) hgrn_state_scan(US, DEC, args.pad);
#endif
    SEAM(3);
#ifdef OLD_P4
    if (IN(4)) { for (int ht = bx; ht < 1024; ht += G) hgrn_out_tile(lds, H, US, hgain, CAT, ht); }
#else
    if (IN(4)) hgrn_out_phase(H, US, hgain, CAT, bx, G);
#endif
    SEAM(4);
    if (IN(5)) {
        pg8::Gemm gm{CAT, WOUT, MROWS, DM, DM}; pg8::StaticOrder so; so.init(MROWS, DM, G, vcu);
        EpiR ep{R, b_out, x};
        pg8::gemm_phase<EpiR, pg8::StaticOrder, false, true>(lds, gm, so, ep);
    }
    SEAM(5);
    if (IN(6)) ln_rows(R, ln_g, ln_b, args.out);
#undef IN
#undef SEAM
}

extern "C" void kernel_launch(void* const* d_in, const int* in_sizes, int n_in, void* d_out, int out_size, void* d_ws, size_t ws_size, hipStream_t stream) {
    static int grid = 0;
    if (grid == 0) {
        int dev = 0, cus = 0, per_cu = 0;
        if (hipGetDevice(&dev) != hipSuccess || hipDeviceGetAttribute(&cus, hipDeviceAttributeMultiprocessorCount, dev) != hipSuccess) { fprintf(stderr, "kernel_launch: device query failed\n"); grid = -1; return; }
        if (hipFuncSetAttribute((const void*)fwd_kernel, hipFuncAttributeMaxDynamicSharedMemorySize, LDS_BYTES) != hipSuccess) { fprintf(stderr, "kernel_launch: hipFuncSetAttribute failed\n"); grid = -1; return; }
        if (hipOccupancyMaxActiveBlocksPerMultiprocessor(&per_cu, (const void*)fwd_kernel, NTHREADS, LDS_BYTES) != hipSuccess || per_cu < 1) { fprintf(stderr, "kernel_launch: occupancy query gave %d\n", per_cu); per_cu = 1; }
        (void)hipGetLastError();
        if (per_cu > 1) per_cu = 1;
        grid = cus * per_cu;
        if (ws_size < 256 * MiB) fprintf(stderr, "kernel_launch: workspace too small (%zu)\n", ws_size);
    }
    if (grid < 0) return;
    Args a{};
    for (int i = 0; i < 11; ++i) a.in[i] = (const float*)d_in[i];
    a.out = (float*)d_out; a.ws = (unsigned char*)d_ws;
#if MK_LAUNCHES == 1
    a.ph_lo = 0; a.ph_hi = 7; a.coop = 1;
    if (hipMemsetAsync((char*)d_ws + WS_CTL, 0, 16384, stream) != hipSuccess) { fprintf(stderr, "kernel_launch: memset failed\n"); return; }
    hipLaunchKernelGGL(fwd_kernel, dim3(grid), dim3(NTHREADS), LDS_BYTES, stream, a);
#else
    for (int p = 0; p < 7; ++p) {
        a.ph_lo = p; a.ph_hi = p + 1; a.coop = 0;
        int reps = 1;
#ifdef PROBE_PHASE
        if (p == PROBE_PHASE) reps = 1 + PROBE_N;
#endif
        for (int q = 0; q < reps; ++q) { a.pad = ((p == 2 || p == 3) && q + 1 < reps) ? 1 : 0; hipLaunchKernelGGL(fwd_kernel, dim3(grid), dim3(NTHREADS), LDS_BYTES, stream, a); }
    }
#endif
}
```

```cpp
#include <hip/hip_runtime.h>
#include <hip/hip_cooperative_groups.h>
#include <cstdio>
#include <cstdint>
namespace cg = cooperative_groups;
#define MK_LAUNCHES 1
namespace pg8 {
#define PG8_LAS __attribute__((address_space(3)))
typedef unsigned short bf16_t;
typedef short bf16x8 __attribute__((ext_vector_type(8)));
typedef float f32x4 __attribute__((ext_vector_type(4)));
typedef unsigned u32x4 __attribute__((ext_vector_type(4)));
constexpr int BM = 256, BK = 64, HALF = 128, HTB = HALF * BK * 2  , STAGE_BYTES = 8 * HTB, NXCD = 8, WGM = 8;

__host__ __device__ __forceinline__ int lds_byte(int r, int c) { const int st = (r >> 4) * 2 + (c >> 5), rr = r & 15, cc = c & 31, ob = rr * 64 + cc * 2; return st * 1024 + (ob ^ (((ob >> 9) & 1) << 5)); }
__host__ __device__ __forceinline__ void stage_rc(int b, int& R, int& C) { const int st = b / 1024, sb = b % 1024, swz = sb ^ (((sb >> 9) & 1) << 5); R = (st >> 1) * 16 + swz / 64; C = (st & 1) * 32 + (swz % 64) / 2; }
__host__ __device__ __forceinline__ int perm32(int rho) { const int n = rho >> 4, i = rho & 15; return 8 * (i >> 2) + 4 * n + (i & 3); }

struct Unit { int pm, pn; };
struct Gemm { const bf16_t* A; const bf16_t* Bt; int M, N, K; };

struct StaticOrder {
    int nM, nN, nwg, G, c;
    __host__ __device__ void init(int M, int N, int G_, int c_) { nM = M / BM; nN = N / BM; nwg = nM * nN; G = G_; c = c_; }
    __host__ __device__ bool next(int i, Unit& u) const {
        const long L = (long)i * G + c; if (L >= nwg) return false;
        int wgid = (int)L; { const int q = nwg / NXCD, r = nwg % NXCD, xcd = wgid % NXCD, off = wgid / NXCD; wgid = (xcd < r ? xcd * (q + 1) : r * (q + 1) + (xcd - r) * q) + off; }
        const int nig = WGM * nN, gid = wgid / nig, fm = gid * WGM, gsz = (nM - fm) < WGM ? (nM - fm) : WGM;
        u.pm = fm + ((wgid % nig) % gsz); u.pn = (wgid % nig) / gsz; return true;
    }
    __device__ __forceinline__ void a_ready(const Unit&) const {}
    __device__ __forceinline__ void done(const Unit&) const {}
};
__device__ __forceinline__ unsigned cvt_pk_bf16(float lo, float hi) { unsigned r; asm volatile("v_cvt_pk_bf16_f32 %0, %1, %2" : "=v"(r) : "v"(lo), "v"(hi)); return r; }
template <class Epi, class Sched, bool ALIGN_EPI = false, bool SP2 = false>
__device__ __forceinline__ void gemm_phase(PG8_LAS unsigned char* lds, const Gemm g, const Sched& S, const Epi& E) {
    const int tid = threadIdx.x, wid = __builtin_amdgcn_readfirstlane(tid >> 6), lane = tid & 63, wr = wid >> 2, wc = wid & 3, fr = lane & 15, fq = lane >> 4;
    const int K = g.K, nt = K / BK;
    unsigned voffA[2], voffB[2];
#pragma unroll
    for (int i = 0; i < 2; ++i) { int R, C; stage_rc(tid * 16 + i * 8192, R, C); const int Rb = Epi::PERM ? ((R & ~31) + perm32(R & 31)) : R;
        voffA[i] = (unsigned)(R * K + C) * 2u; voffB[i] = (unsigned)(Rb * K + C) * 2u; }
    const size_t kstep = (size_t)(BK * 2);
    const size_t hstep = (size_t)HALF * K * 2;
    const size_t tstep = 2 * hstep;
    const unsigned ldsw = (unsigned)wid * 1024u;
    const int aoff = lds_byte(wr * 64 + fr, fq * 8), boff = lds_byte(wc * 32 + fr, fq * 8);
#define PG8_SA(b, h) (((b) * 2 + (h)) * HTB)
#define PG8_SB(b, h) ((4 + (b) * 2 + (h)) * HTB)
#define PG8_STAGE(bufoff, gbase, voff) do { _Pragma("unroll") for (int _i = 0; _i < 2; ++_i) \
        __builtin_amdgcn_global_load_lds((const unsigned*)((const char*)(gbase) + (voff)[_i]), (PG8_LAS unsigned*)(lds + (bufoff) + ldsw + _i * 8192), 16, 0, 0); } while (0)
#define PG8_LDA(dst, b, h) do { _Pragma("unroll") for (int m = 0; m < 4; ++m) _Pragma("unroll") for (int k = 0; k < 2; ++k) dst[m][k] = *(const PG8_LAS bf16x8*)(lds + PG8_SA(b, h) + aoff + m * 2048 + k * 1024); } while (0)
#define PG8_LDB(dst, b, h) do { _Pragma("unroll") for (int n = 0; n < 2; ++n) _Pragma("unroll") for (int k = 0; k < 2; ++k) dst[n][k] = *(const PG8_LAS bf16x8*)(lds + PG8_SB(b, h) + boff + n * 2048 + k * 1024); } while (0)
#define PG8_MMA(ai, bj, At, Bt) do { __builtin_amdgcn_s_setprio(1); _Pragma("unroll") for (int m = 0; m < 4; ++m) _Pragma("unroll") for (int n = 0; n < 2; ++n) _Pragma("unroll") for (int k = 0; k < 2; ++k) \
        acc[ai][bj][m][n] = __builtin_amdgcn_mfma_f32_16x16x32_bf16(Bt[n][k], At[m][k], acc[ai][bj][m][n], 0, 0, 0); __builtin_amdgcn_s_setprio(0); } while (0)
#define PG8_WAIT_V(n) asm volatile("s_waitcnt vmcnt(" #n ")" ::: "memory")
#define PG8_WAIT_L(n) asm volatile("s_waitcnt lgkmcnt(" #n ")" ::: "memory")
#define PG8_BAR __builtin_amdgcn_s_barrier()
#define PG8_SCHED __builtin_amdgcn_sched_barrier(0)
    Unit cur, nxt; int ui = 0;
    if (!S.next(0, cur)) return;
    f32x4 acc[2][2][4][2];
#pragma unroll
    for (int a = 0; a < 2; ++a)
#pragma unroll
        for (int b = 0; b < 2; ++b)
#pragma unroll
            for (int m = 0; m < 4; ++m)
#pragma unroll
                for (int n = 0; n < 2; ++n) acc[a][b][m][n] = (f32x4){0.f, 0.f, 0.f, 0.f};
    bf16x8 At[4][2], B0[2][2], B1[2][2];
    const char* cA = (const char*)g.A + (size_t)cur.pm * tstep; const char* cB = (const char*)g.Bt + (size_t)cur.pn * tstep;
    S.a_ready(cur);
    if constexpr (SP2) {
        PG8_STAGE(PG8_SB(0, 0), cB, voffB); PG8_STAGE(PG8_SB(0, 1), cB + hstep, voffB); PG8_STAGE(PG8_SA(0, 0), cA, voffA); PG8_STAGE(PG8_SA(0, 1), cA + hstep, voffA);
        if (wr == 1) PG8_BAR;
        PG8_WAIT_V(2); PG8_BAR;
        PG8_STAGE(PG8_SB(1, 0), cB + kstep, voffB); PG8_STAGE(PG8_SA(1, 0), cA + kstep, voffA); PG8_STAGE(PG8_SB(1, 1), cB + hstep + kstep, voffB);
        PG8_WAIT_V(6); PG8_BAR;
    } else {
        PG8_STAGE(PG8_SB(0, 0), cB, voffB); PG8_STAGE(PG8_SA(0, 0), cA, voffA); PG8_STAGE(PG8_SB(0, 1), cB + hstep, voffB); PG8_STAGE(PG8_SA(0, 1), cA + hstep, voffA);
        if (wr == 1) PG8_BAR;
        PG8_WAIT_V(4); PG8_BAR;
        PG8_STAGE(PG8_SB(1, 0), cB + kstep, voffB); PG8_STAGE(PG8_SA(1, 0), cA + kstep, voffA); PG8_STAGE(PG8_SB(1, 1), cB + hstep + kstep, voffB);
        PG8_WAIT_V(6); PG8_BAR;
    }
    for (;;) {
        const bool has_next = S.next(ui + 1, nxt);
        const char* nA = has_next ? (const char*)g.A + (size_t)nxt.pm * tstep : cA; const char* nB = has_next ? (const char*)g.Bt + (size_t)nxt.pn * tstep : cB;
        for (int t = 0; t < nt; t += 2) {
            const bool last = (t == nt - 2);
            const char* a1 = cA + (size_t)(t + 1) * kstep;
            const char* a2 = last ? nA : cA + (size_t)(t + 2) * kstep; const char* b2 = last ? nB : cB + (size_t)(t + 2) * kstep;
            const char* a3 = a2 + kstep; const char* b3 = b2 + kstep;
            if (last && has_next) S.a_ready(nxt);
            if constexpr (SP2) {
            PG8_LDB(B0, 0, 0); PG8_LDB(B1, 0, 1); PG8_SCHED; PG8_LDA(At, 0, 0); PG8_STAGE(PG8_SA(1, 1), a1 + hstep, voffA);
            PG8_WAIT_V(8); PG8_WAIT_L(0); PG8_BAR; PG8_MMA(0, 0, At, B0); PG8_MMA(0, 1, At, B1); PG8_BAR; PG8_SCHED;
            PG8_LDA(At, 0, 1); PG8_STAGE(PG8_SB(0, 0), b2, voffB); PG8_STAGE(PG8_SB(0, 1), b2 + hstep, voffB); PG8_STAGE(PG8_SA(0, 0), a2, voffA);
            PG8_WAIT_V(8); PG8_WAIT_L(0); PG8_BAR; PG8_MMA(1, 0, At, B0); PG8_MMA(1, 1, At, B1); PG8_BAR; PG8_SCHED;
            PG8_LDB(B0, 1, 0); PG8_LDB(B1, 1, 1); PG8_SCHED; PG8_LDA(At, 1, 0); PG8_STAGE(PG8_SA(0, 1), a2 + hstep, voffA);
            PG8_WAIT_V(8); PG8_WAIT_L(0); PG8_BAR; PG8_MMA(0, 0, At, B0); PG8_MMA(0, 1, At, B1); PG8_BAR; PG8_SCHED;
            PG8_LDA(At, 1, 1); PG8_STAGE(PG8_SB(1, 0), b3, voffB); PG8_STAGE(PG8_SB(1, 1), b3 + hstep, voffB); PG8_STAGE(PG8_SA(1, 0), a3, voffA);
            PG8_WAIT_V(8); PG8_WAIT_L(0); PG8_BAR; PG8_MMA(1, 0, At, B0); PG8_MMA(1, 1, At, B1); PG8_BAR; PG8_SCHED;
            } else {
            PG8_LDB(B0, 0, 0); PG8_SCHED; PG8_LDA(At, 0, 0); PG8_STAGE(PG8_SA(1, 1), a1 + hstep, voffA);
            PG8_WAIT_L(8); PG8_BAR; PG8_WAIT_L(0); PG8_MMA(0, 0, At, B0); PG8_BAR; PG8_SCHED;
            PG8_LDB(B1, 0, 1); PG8_STAGE(PG8_SB(0, 0), b2, voffB);
            PG8_BAR; PG8_WAIT_L(0); PG8_MMA(0, 1, At, B1); PG8_BAR;
            PG8_LDA(At, 0, 1); PG8_STAGE(PG8_SA(0, 0), a2, voffA);
            PG8_BAR; PG8_WAIT_L(0); PG8_MMA(1, 0, At, B0); PG8_BAR; PG8_SCHED;
            PG8_STAGE(PG8_SB(0, 1), b2 + hstep, voffB);
            PG8_WAIT_V(6); PG8_BAR; PG8_MMA(1, 1, At, B1); PG8_BAR;
            PG8_LDB(B0, 1, 0); PG8_SCHED; PG8_LDA(At, 1, 0); PG8_STAGE(PG8_SA(0, 1), a2 + hstep, voffA);
            PG8_WAIT_L(8); PG8_BAR; PG8_WAIT_L(0); PG8_MMA(0, 0, At, B0); PG8_BAR; PG8_SCHED;
            PG8_LDB(B1, 1, 1); PG8_STAGE(PG8_SB(1, 0), b3, voffB);
            PG8_BAR; PG8_WAIT_L(0); PG8_MMA(0, 1, At, B1); PG8_BAR;
            PG8_LDA(At, 1, 1); PG8_STAGE(PG8_SA(1, 0), a3, voffA);
            PG8_BAR; PG8_WAIT_L(0); PG8_MMA(1, 0, At, B0); PG8_BAR; PG8_SCHED;
            PG8_STAGE(PG8_SB(1, 1), b3 + hstep, voffB);
            PG8_WAIT_V(6); PG8_BAR; PG8_MMA(1, 1, At, B1); PG8_BAR;
            }
        }
        if constexpr (ALIGN_EPI) { if (wr == 0) PG8_BAR; }
        if constexpr (!Epi::AFTER_DRAIN) { E(acc, cur, wr, wc, fr, fq); S.done(cur); }
        if (!has_next) break;
#pragma unroll
        for (int a = 0; a < 2; ++a)
#pragma unroll
            for (int b = 0; b < 2; ++b)
#pragma unroll
                for (int m = 0; m < 4; ++m)
#pragma unroll
                    for (int n = 0; n < 2; ++n) acc[a][b][m][n] = (f32x4){0.f, 0.f, 0.f, 0.f};
        cur = nxt; cA = nA; cB = nB; ++ui;
        if constexpr (ALIGN_EPI) { if (wr == 1) PG8_BAR; }
    }
    PG8_WAIT_V(0);
    if constexpr (!ALIGN_EPI) { if (wr == 0) PG8_BAR; }
    PG8_BAR;
    if constexpr (Epi::AFTER_DRAIN) { E.fused(acc, cur, wr, wc, fr, fq, lds, wid, lane); S.done(cur); }
#undef PG8_SA
#undef PG8_SB
#undef PG8_STAGE
#undef PG8_LDA
#undef PG8_LDB
#undef PG8_MMA
#undef PG8_WAIT_V
#undef PG8_WAIT_L
#undef PG8_BAR
#undef PG8_SCHED
}
}

#ifndef MK_LAUNCHES
#define MK_LAUNCHES 1
#endif
#define LAS __attribute__((address_space(3)))
typedef unsigned short bf16_t;
typedef short bf16x8 __attribute__((ext_vector_type(8)));
typedef float f32x4 __attribute__((ext_vector_type(4)));
typedef unsigned u32x4 __attribute__((ext_vector_type(4)));
typedef unsigned u32x2 __attribute__((ext_vector_type(2)));

constexpr int NTHREADS = 512;
constexpr int BATCH = 2, SEQ = 8192, DM = 1024, MROWS = BATCH * SEQ, DIN = 4608;
constexpr int C_QA = 0, C_KA = 512, C_VA = 1024, C_GA = 1536, C_QH = 2048, C_ZF = 2560, C_ZB = 3072, C_IH = 3584, C_GH = 4096;
constexpr float ALPHA = 1.189207115002721f;
constexpr size_t MiB = 1u << 20;
constexpr size_t WS_US = 0;
constexpr size_t WS_WIN = 64 * MiB, WS_WOUT = 73 * MiB, WS_DEC = 75 * MiB, WS_CTL = 77 * MiB;
constexpr size_t WS_H = 80 * MiB;
constexpr size_t WS_CAT = 224 * MiB;
constexpr int LDS_BYTES = 160768;

struct Args { const float* in[11]; float* out; unsigned char* ws; int ph_lo, ph_hi, coop, pad; };

__device__ __forceinline__ float bf2f(unsigned v) { return __builtin_bit_cast(float, v << 16); }
__device__ __forceinline__ unsigned f2bf(float f) { unsigned u = __builtin_bit_cast(unsigned, f); return (u + 0x7fffu + ((u >> 16) & 1u)) >> 16; }
typedef float f32x2_t __attribute__((ext_vector_type(2)));
typedef __bf16 bf16x2_t __attribute__((ext_vector_type(2)));
__device__ __forceinline__ unsigned pk2(float lo, float hi) { f32x2_t v = {lo, hi}; bf16x2_t b = __builtin_convertvector(v, bf16x2_t); return __builtin_bit_cast(unsigned, b); }
__device__ __forceinline__ float sigmoidf_(float z) { return 1.f / (1.f + __expf(-z)); }
__device__ __forceinline__ float siluf_(float z) { return z / (1.f + __expf(-z)); }
__device__ __forceinline__ bf16x8 as_bf16x8(u32x4 v) { return __builtin_bit_cast(bf16x8, v); }

struct EpiH {
    static constexpr bool PERM = true, AFTER_DRAIN = false;
    bf16_t* O; const float* bias;
    __device__ __forceinline__ void operator()(const f32x4 (&acc)[2][2][4][2], const pg8::Unit& u, int wr, int wc, int fr, int fq) const {
        const int row0 = u.pm * 256 + wr * 64 + fr, col0 = u.pn * 256 + wc * 32 + 8 * fq;
        f32x4 bv[2][2];
#pragma unroll
        for (int bj = 0; bj < 2; ++bj)
#pragma unroll
            for (int n = 0; n < 2; ++n) bv[bj][n] = *(const f32x4*)(bias + col0 + bj * 128 + 4 * n);
#pragma unroll
        for (int ai = 0; ai < 2; ++ai)
#pragma unroll
            for (int m = 0; m < 4; ++m) { bf16_t* rowp = O + (size_t)(row0 + ai * 128 + m * 16) * DIN + col0;
#pragma unroll
                for (int bj = 0; bj < 2; ++bj) { f32x4 v0 = acc[ai][bj][m][0] + bv[bj][0], v1 = acc[ai][bj][m][1] + bv[bj][1];
                    u32x4 w; w.x = pk2(v0[0], v0[1]); w.y = pk2(v0[2], v0[3]); w.z = pk2(v1[0], v1[1]); w.w = pk2(v1[2], v1[3]);
                    *(u32x4*)(rowp + bj * 128) = w; } }
    }
};
struct EpiR {
    static constexpr bool PERM = false, AFTER_DRAIN = false;
    float* R; const float* bias; const float* x;
    __device__ __forceinline__ void operator()(const f32x4 (&acc)[2][2][4][2], const pg8::Unit& u, int wr, int wc, int fr, int fq) const {
        const int row0 = u.pm * 256 + wr * 64 + fr, col0 = u.pn * 256 + wc * 32 + 4 * fq;
        f32x4 bv[2][2];
#pragma unroll
        for (int bj = 0; bj < 2; ++bj)
#pragma unroll
            for (int n = 0; n < 2; ++n) bv[bj][n] = *(const f32x4*)(bias + col0 + bj * 128 + n * 16);
#pragma unroll
        for (int ai = 0; ai < 2; ++ai)
#pragma unroll
            for (int m = 0; m < 4; ++m) { const size_t ro = (size_t)(row0 + ai * 128 + m * 16) * DM + col0;
#pragma unroll
                for (int bj = 0; bj < 2; ++bj)
#pragma unroll
                    for (int n = 0; n < 2; ++n) { const f32x4 xv = *(const f32x4*)(x + ro + bj * 128 + n * 16);
                        *(f32x4*)(R + ro + bj * 128 + n * 16) = acc[ai][bj][m][n] + bv[bj][n] + xv * ALPHA; } }
    }
};

__device__ __forceinline__ void p0_convert(const float* x, const float* w_in, const float* w_out, bf16_t* XB, bf16_t* WIN, bf16_t* WOUT) {
    const int gt = blockIdx.x * NTHREADS + threadIdx.x, GT = gridDim.x * NTHREADS;
    for (int i = gt; i < MROWS * DM / 8; i += 4 * GT) {
        f32x4 a[4], b[4];
#pragma unroll
        for (int k = 0; k < 4; ++k) if (i + k * GT < MROWS * DM / 8) { const size_t o = (size_t)(i + k * GT) * 8; a[k] = __builtin_nontemporal_load((const f32x4*)(x + o)); b[k] = __builtin_nontemporal_load((const f32x4*)(x + o + 4)); }
#pragma unroll
        for (int k = 0; k < 4; ++k) if (i + k * GT < MROWS * DM / 8) { u32x4 w; w.x = pk2(a[k][0], a[k][1]); w.y = pk2(a[k][2], a[k][3]); w.z = pk2(b[k][0], b[k][1]); w.w = pk2(b[k][2], b[k][3]);
            *(u32x4*)(XB + (size_t)(i + k * GT) * 8) = w; }
    }
    for (int i = gt; i < DIN * 128; i += GT) {
        const int n = i % DIN, kb = i / DIN; float v[8];
#pragma unroll
        for (int j = 0; j < 8; ++j) v[j] = w_in[(size_t)(kb * 8 + j) * DIN + n];
        u32x4 w; w.x = pk2(v[0], v[1]); w.y = pk2(v[2], v[3]); w.z = pk2(v[4], v[5]); w.w = pk2(v[6], v[7]);
        *(u32x4*)(WIN + (size_t)n * 1024 + kb * 8) = w;
    }
    for (int i = gt; i < DM * 128; i += GT) {
        const int n = i % DM, kb = i / DM; float v[8];
#pragma unroll
        for (int j = 0; j < 8; ++j) v[j] = w_out[(size_t)(kb * 8 + j) * DM + n];
        u32x4 w; w.x = pk2(v[0], v[1]); w.y = pk2(v[2], v[3]); w.z = pk2(v[4], v[5]); w.w = pk2(v[6], v[7]);
        *(u32x4*)(WOUT + (size_t)n * 1024 + kb * 8) = w;
    }
}

constexpr int AT_VP = 520;
constexpr int AT_RPB_OFF = 2 * 64 * AT_VP * 2;
__device__ __forceinline__ void attn_tile(LAS unsigned char* lds, const bf16_t* H, const float* rpb, bf16_t* CAT, int at) {
    const int tid = threadIdx.x, lane = tid & 63, w = tid >> 6, fr = lane & 15, g = lane >> 4;
    const int b = at >> 9, hp = (at >> 7) & 3, r = at & 127;
    int rs = r - 4; rs = rs < 0 ? 0 : (rs > 120 ? 120 : rs);
    LAS bf16_t* VT = (LAS bf16_t*)lds;
    LAS float* RPB = (LAS float*)(lds + AT_RPB_OFF);
    {
        const size_t tok = (size_t)b * SEQ + (size_t)(rs + (tid >> 6)) * 64 + (tid & 63);
#pragma unroll
        for (int hh = 0; hh < 2; ++hh) {
            const bf16_t* src = H + tok * DIN + C_VA + (2 * hp + hh) * 64;
#pragma unroll
            for (int p = 0; p < 8; ++p) {
                const u32x4 v = *(const u32x4*)(src + 8 * p);
#pragma unroll
                for (int i = 0; i < 4; ++i) {
                    VT[(hh * 64 + 8 * p + 2 * i) * AT_VP + tid] = (bf16_t)(v[i] & 0xffffu);
                    VT[(hh * 64 + 8 * p + 2 * i + 1) * AT_VP + tid] = (bf16_t)(v[i] >> 16);
                }
            }
        }
        for (int i = tid; i < 930; i += NTHREADS) RPB[i] = rpb[hp * 930 + i];
    }
    __syncthreads();
    const int hh = w >> 2, j = w & 3, head = 2 * hp + hh;
    const int kc0 = (j == 0) ? 0 : (j == 1 ? 8 : (j == 2 ? 24 : 32));
    const size_t qtok = (size_t)b * SEQ + (size_t)r * 64 + 16 * j + fr;
    bf16x8 qf[2];
#pragma unroll
    for (int ks = 0; ks < 2; ++ks) qf[ks] = as_bf16x8(*(const u32x4*)(H + qtok * DIN + C_QA + head * 64 + ks * 32 + 8 * g));
    f32x4 S[16];
#pragma unroll
    for (int kt = 0; kt < 16; ++kt) {
        const int a = kt >> 1, ch = kt & 1;
        const size_t ktok = (size_t)b * SEQ + (size_t)(rs + a) * 64 + kc0 + 16 * ch + fr;
        const bf16_t* kp = H + ktok * DIN + C_KA + head * 64 + 8 * g;
        const bf16x8 k0 = as_bf16x8(*(const u32x4*)(kp)), k1 = as_bf16x8(*(const u32x4*)(kp + 32));
        f32x4 acc = {0.f, 0.f, 0.f, 0.f};
        acc = __builtin_amdgcn_mfma_f32_16x16x32_bf16(k0, qf[0], acc, 0, 0, 0);
        acc = __builtin_amdgcn_mfma_f32_16x16x32_bf16(k1, qf[1], acc, 0, 0, 0);
        S[kt] = acc;
    }
    const int qcol = 16 * j + fr;
    int cs = qcol - 8; cs = cs < 0 ? 0 : (cs > 48 ? 48 : cs);
    float mx = -1e30f;
#pragma unroll
    for (int kt = 0; kt < 16; ++kt) {
        const int a = kt >> 1, ch = kt & 1;
        const int dr = rs + a - r + 7;
#pragma unroll
        for (int rg = 0; rg < 4; ++rg) {
            const int kcol = kc0 + 16 * ch + 4 * g + rg;
            int dc = kcol - qcol + 15; dc = dc < 0 ? 0 : (dc > 30 ? 30 : dc);
            const bool inw = (unsigned)(kcol - cs) < 16u;
            const float s = S[kt][rg] * 0.125f + RPB[hh * 465 + dr * 31 + dc];
            S[kt][rg] = inw ? s : -1e30f;
            mx = fmaxf(mx, S[kt][rg]);
        }
    }
    mx = fmaxf(mx, __shfl_xor(mx, 16)); mx = fmaxf(mx, __shfl_xor(mx, 32));
    float sum = 0.f;
#pragma unroll
    for (int kt = 0; kt < 16; ++kt)
#pragma unroll
        for (int rg = 0; rg < 4; ++rg) { const float p = __expf(S[kt][rg] - mx); S[kt][rg] = p; sum += p; }
    sum += __shfl_xor(sum, 16); sum += __shfl_xor(sum, 32);
    f32x4 O[4];
#pragma unroll
    for (int mt = 0; mt < 4; ++mt) O[mt] = (f32x4){0.f, 0.f, 0.f, 0.f};
#pragma unroll
    for (int kk = 0; kk < 8; ++kk) {
        u32x4 pw; pw.x = pk2(S[2 * kk][0], S[2 * kk][1]); pw.y = pk2(S[2 * kk][2], S[2 * kk][3]);
        pw.z = pk2(S[2 * kk + 1][0], S[2 * kk + 1][1]); pw.w = pk2(S[2 * kk + 1][2], S[2 * kk + 1][3]);
        const bf16x8 pf = as_bf16x8(pw);
        const int key1 = kk * 64 + kc0 + 4 * g;
#pragma unroll
        for (int mt = 0; mt < 4; ++mt) {
            const LAS bf16_t* vp = VT + (hh * 64 + 16 * mt + fr) * AT_VP + key1;
            const u32x2 lo = *(const LAS u32x2*)(vp), hi = *(const LAS u32x2*)(vp + 16);
            u32x4 vw; vw.x = lo.x; vw.y = lo.y; vw.z = hi.x; vw.w = hi.y;
            O[mt] = __builtin_amdgcn_mfma_f32_16x16x32_bf16(as_bf16x8(vw), pf, O[mt], 0, 0, 0);
        }
    }
    const float inv = 1.f / sum;
#pragma unroll
    for (int mt = 0; mt < 4; ++mt) {
        const int e = 16 * mt + 4 * g;
        const u32x2 gw = *(const u32x2*)(H + qtok * DIN + C_GA + head * 64 + e);
        const float g0 = bf2f(gw.x & 0xffffu), g1 = bf2f(gw.x >> 16), g2 = bf2f(gw.y & 0xffffu), g3 = bf2f(gw.y >> 16);
        u32x2 ow; ow.x = pk2(O[mt][0] * inv * siluf_(g0), O[mt][1] * inv * siluf_(g1)); ow.y = pk2(O[mt][2] * inv * siluf_(g2), O[mt][3] * inv * siluf_(g3));
        *(u32x2*)(CAT + qtok * DM + head * 64 + e) = ow;
    }
    __syncthreads();
}

constexpr int AR_KP = 72, AR_VP = 520;
constexpr int AR_KR = 0, AR_VR = 73728, AR_MG = 140288, AR_RPB = 158720;
__device__ __forceinline__ int at_clip_rs(int r) { int rs = r - 4; return rs < 0 ? 0 : (rs > 120 ? 120 : rs); }
__device__ __forceinline__ void attn_phase(LAS unsigned char* lds, const bf16_t* H, const float* rpb, bf16_t* CAT, int bx, int G) {
    const int tid = threadIdx.x, lane = tid & 63, w = tid >> 6, fr = lane & 15, g = lane >> 4;
    LAS bf16_t* KR = (LAS bf16_t*)(lds + AR_KR); LAS bf16_t* VR = (LAS bf16_t*)(lds + AR_VR); LAS float* MG = (LAS float*)(lds + AR_MG); LAS float* RPB = (LAS float*)(lds + AR_RPB);
    const int j = w & 3, half = w >> 2;
    const int kc0 = (j == 0) ? 0 : (j == 1 ? 8 : (j == 2 ? 24 : 32));
    const int skey = tid >> 3, spiece = tid & 7, vkey = tid & 63, vpiece = tid >> 6;
    const int qcol = 16 * j + fr;
    int cs = qcol - 8; cs = cs < 0 ? 0 : (cs > 48 ? 48 : cs);
    for (int u = bx; u < 256; u += G) {
        const int b = u >> 7, h = (u >> 4) & 7, r0 = (u & 15) * 8;
        const bf16_t* Hb = H + (size_t)b * SEQ * DIN;
        for (int i = tid; i < 465; i += NTHREADS) RPB[i] = rpb[h * 465 + i];
        {
            const int rs0 = at_clip_rs(r0);
            u32x4 kreg[8], vreg[8];
#pragma unroll
            for (int a = 0; a < 8; ++a) {
                kreg[a] = *(const u32x4*)(Hb + (size_t)((rs0 + a) * 64 + skey) * DIN + C_KA + h * 64 + spiece * 8);
                vreg[a] = *(const u32x4*)(Hb + (size_t)((rs0 + a) * 64 + vkey) * DIN + C_VA + h * 64 + vpiece * 8);
            }
#pragma unroll
            for (int a = 0; a < 8; ++a) {
                const int slot = (rs0 + a) & 7;
                *(LAS u32x4*)(KR + (slot * 64 + skey) * AR_KP + spiece * 8) = kreg[a];
#pragma unroll
                for (int i = 0; i < 4; ++i) {
                    VR[(vpiece * 8 + 2 * i) * AR_VP + slot * 64 + vkey] = (bf16_t)(vreg[a][i] & 0xffffu);
                    VR[(vpiece * 8 + 2 * i + 1) * AR_VP + slot * 64 + vkey] = (bf16_t)(vreg[a][i] >> 16);
                }
            }
        }
        __syncthreads();
        for (int r = r0; r < r0 + 8; ++r) {
            const int rs = at_clip_rs(r), rsn = at_clip_rs(r + 1);
            const bool need = (r + 1 < r0 + 8) && (rsn > rs);
            u32x4 kn = {0u, 0u, 0u, 0u}, vn = {0u, 0u, 0u, 0u};
            if (need) {
                kn = *(const u32x4*)(Hb + (size_t)((rsn + 7) * 64 + skey) * DIN + C_KA + h * 64 + spiece * 8);
                vn = *(const u32x4*)(Hb + (size_t)((rsn + 7) * 64 + vkey) * DIN + C_VA + h * 64 + vpiece * 8);
            }
            const size_t qoff = (size_t)(r * 64 + qcol);
            bf16x8 qf[2];
#pragma unroll
            for (int ks = 0; ks < 2; ++ks) qf[ks] = as_bf16x8(*(const u32x4*)(Hb + qoff * DIN + C_QA + h * 64 + ks * 32 + 8 * g));
            u32x2 gw[4];
            if (half == 0) {
#pragma unroll
                for (int mt = 0; mt < 4; ++mt) gw[mt] = *(const u32x2*)(Hb + qoff * DIN + C_GA + h * 64 + 16 * mt + 4 * g);
            }
            f32x4 S[8];
#pragma unroll
            for (int a4 = 0; a4 < 4; ++a4) {
                const int slot = (rs + 4 * half + a4) & 7;
#pragma unroll
                for (int ch = 0; ch < 2; ++ch) {
                    const LAS bf16_t* kp = KR + (slot * 64 + kc0 + 16 * ch + fr) * AR_KP + 8 * g;
                    const bf16x8 k0 = *(const LAS bf16x8*)(kp), k1 = *(const LAS bf16x8*)(kp + 32);
                    f32x4 acc = {0.f, 0.f, 0.f, 0.f};
                    acc = __builtin_amdgcn_mfma_f32_16x16x32_bf16(k0, qf[0], acc, 0, 0, 0);
                    acc = __builtin_amdgcn_mfma_f32_16x16x32_bf16(k1, qf[1], acc, 0, 0, 0);
                    S[a4 * 2 + ch] = acc;
                }
            }
            float mx = -1e30f;
#pragma unroll
            for (int kt = 0; kt < 8; ++kt) {
                const int a4 = kt >> 1, ch = kt & 1;
                const int dr = rs + 4 * half + a4 - r + 7;
#pragma unroll
                for (int rg = 0; rg < 4; ++rg) {
                    const int kcol = kc0 + 16 * ch + 4 * g + rg;
                    int dc = kcol - qcol + 15; dc = dc < 0 ? 0 : (dc > 30 ? 30 : dc);
                    const bool inw = (unsigned)(kcol - cs) < 16u;
                    const float sv = S[kt][rg] * 0.125f + RPB[dr * 31 + dc];
                    S[kt][rg] = inw ? sv : -1e30f;
                    mx = fmaxf(mx, S[kt][rg]);
                }
            }
            mx = fmaxf(mx, __shfl_xor(mx, 16)); mx = fmaxf(mx, __shfl_xor(mx, 32));
            float sum = 0.f;
#pragma unroll
            for (int kt = 0; kt < 8; ++kt)
#pragma unroll
                for (int rg = 0; rg < 4; ++rg) { const float pv = __expf(S[kt][rg] - mx); S[kt][rg] = pv; sum += pv; }
            sum += __shfl_xor(sum, 16); sum += __shfl_xor(sum, 32);
            f32x4 O[4];
#pragma unroll
            for (int mt = 0; mt < 4; ++mt) O[mt] = (f32x4){0.f, 0.f, 0.f, 0.f};
#pragma unroll
            for (int kk = 0; kk < 4; ++kk) {
                u32x4 pw; pw.x = pk2(S[2 * kk][0], S[2 * kk][1]); pw.y = pk2(S[2 * kk][2], S[2 * kk][3]);
                pw.z = pk2(S[2 * kk + 1][0], S[2 * kk + 1][1]); pw.w = pk2(S[2 * kk + 1][2], S[2 * kk + 1][3]);
                const bf16x8 pf = as_bf16x8(pw);
                const int slot = (rs + 4 * half + kk) & 7;
#pragma unroll
                for (int mt = 0; mt < 4; ++mt) {
                    const LAS bf16_t* vp = VR + (16 * mt + fr) * AR_VP + slot * 64 + kc0 + 4 * g;
                    const u32x2 lo = *(const LAS u32x2*)(vp), hi = *(const LAS u32x2*)(vp + 16);
                    u32x4 vw; vw.x = lo.x; vw.y = lo.y; vw.z = hi.x; vw.w = hi.y;
                    O[mt] = __builtin_amdgcn_mfma_f32_16x16x32_bf16(as_bf16x8(vw), pf, O[mt], 0, 0, 0);
                }
            }
            if (half == 1) {
                LAS float* mg = MG + (w - 4) * 18 * 64 + lane;
#pragma unroll
                for (int mt = 0; mt < 4; ++mt)
#pragma unroll
                    for (int rg = 0; rg < 4; ++rg) mg[(mt * 4 + rg) * 64] = O[mt][rg];
                mg[16 * 64] = mx; mg[17 * 64] = sum;
            }
            __syncthreads();
            if (half == 0) {
                const LAS float* mg = MG + w * 18 * 64 + lane;
                const float m1 = mg[16 * 64], l1 = mg[17 * 64];
                const float M = fmaxf(mx, m1), f0 = __expf(mx - M), f1 = __expf(m1 - M);
                const float inv = 1.f / (sum * f0 + l1 * f1);
#pragma unroll
                for (int mt = 0; mt < 4; ++mt) {
                    float o[4];
#pragma unroll
                    for (int rg = 0; rg < 4; ++rg) o[rg] = (O[mt][rg] * f0 + mg[(mt * 4 + rg) * 64] * f1) * inv;
                    const float g0 = bf2f(gw[mt].x & 0xffffu), g1 = bf2f(gw[mt].x >> 16), g2 = bf2f(gw[mt].y & 0xffffu), g3 = bf2f(gw[mt].y >> 16);
                    u32x2 ow; ow.x = pk2(o[0] * siluf_(g0), o[1] * siluf_(g1)); ow.y = pk2(o[2] * siluf_(g2), o[3] * siluf_(g3));
                    *(u32x2*)(CAT + ((size_t)b * SEQ + qoff) * DM + h * 64 + 16 * mt + 4 * g) = ow;
                }
            }
            __syncthreads();
            if (need) {
                const int slot = (rsn + 7) & 7;
                *(LAS u32x4*)(KR + (slot * 64 + skey) * AR_KP + spiece * 8) = kn;
#pragma unroll
                for (int i = 0; i < 4; ++i) {
                    VR[(vpiece * 8 + 2 * i) * AR_VP + slot * 64 + vkey] = (bf16_t)(vn[i] & 0xffffu);
                    VR[(vpiece * 8 + 2 * i + 1) * AR_VP + slot * 64 + vkey] = (bf16_t)(vn[i] >> 16);
                }
                __syncthreads();
            }
        }
    }
}

#ifdef OLD_P2B
constexpr int OHG_QS = 0, OHG_VT = 16384, OHG_LF = 34816, OHG_ZS = 67584, OHG_QT = 83968, OHG_KP = 101376, OHG_KPT = 118784, OHG_TOT = 137216, OHG_DECS = 139264;
constexpr int OHG_VP = 72, OHG_QP = 136;
__device__ __forceinline__ void hgrn_local_tile(LAS unsigned char* lds, bf16_t* H, const float* lbf, const float* lbb, bf16_t* US, float* DEC, int ht) {
    const int tid = threadIdx.x, lane = tid & 63, w = tid >> 6, fr = lane & 15, g = lane >> 4;
    const int b = ht >> 9, h = (ht >> 7) & 3, c = ht & 127;
    const size_t tok0 = (size_t)b * SEQ + (size_t)c * 64;
    LAS bf16_t* QS = (LAS bf16_t*)(lds + OHG_QS); LAS bf16_t* VT = (LAS bf16_t*)(lds + OHG_VT); LAS float* LF = (LAS float*)(lds + OHG_LF);
    LAS bf16_t* ZS = (LAS bf16_t*)(lds + OHG_ZS); LAS bf16_t* QT = (LAS bf16_t*)(lds + OHG_QT); LAS bf16_t* KP = (LAS bf16_t*)(lds + OHG_KP);
    LAS bf16_t* KPT = (LAS bf16_t*)(lds + OHG_KPT); LAS float* TOT = (LAS float*)(lds + OHG_TOT); LAS float* DECS = (LAS float*)(lds + OHG_DECS);
#pragma unroll
    for (int i = 0; i < 2; ++i) {
        const int p = tid + i * NTHREADS, s = p >> 4, d8 = (p & 15) * 8;
        const bf16_t* rowp = H + (tok0 + s) * DIN + h * 128 + d8;
        *(LAS u32x4*)(QS + s * 128 + d8) = *(const u32x4*)(rowp + C_QH);
        const u32x4 v = *(const u32x4*)(rowp + C_IH);
#pragma unroll
        for (int k = 0; k < 4; ++k) { VT[(d8 + 2 * k) * OHG_VP + s] = (bf16_t)(v[k] & 0xffffu); VT[(d8 + 2 * k + 1) * OHG_VP + s] = (bf16_t)(v[k] >> 16); }
    }
    const int d = tid & 127, sq = tid >> 7;
    const int tt = w & 3, eh = w >> 2;
    f32x4 OI[4];
#pragma unroll
    for (int nt = 0; nt < 4; ++nt) OI[nt] = (f32x4){0.f, 0.f, 0.f, 0.f};
    for (int dir = 0; dir < 2; ++dir) {
        const float* lbl = dir ? lbb : lbf;
        const float lb = 1.f / (1.f + __expf(lbl[512 + h * 128 + d] - lbl[h * 128 + d]));
        const int zc = dir ? C_ZB : C_ZF;
#pragma unroll
        for (int i = 0; i < 2; ++i) {
            const int p = tid + i * NTHREADS, s = p >> 4, d8 = (p & 15) * 8;
            *(LAS u32x4*)(ZS + s * 128 + d8) = *(const u32x4*)(H + (tok0 + s) * DIN + zc + h * 128 + d8);
        }
        __syncthreads();
        float kreg[16];
#pragma unroll
        for (int i = 0; i < 16; ++i) {
            const int s = sq + 4 * i;
            const float z = bf2f(ZS[s * 128 + d]);
            const float ez = __expf(-z), sg = 1.f / (1.f + ez);
            const float f = lb + (1.f - lb) * sg;
            LF[s * 128 + d] = __logf(f);
            kreg[i] = (1.f - lb) * (1.f - sg);
        }
        __syncthreads();
        {
            float run = 0.f;
#pragma unroll
            for (int i = 0; i < 16; ++i) {
                const int s = dir ? (16 * sq + 15 - i) : (16 * sq + i);
                run += LF[s * 128 + d]; LF[s * 128 + d] = run;
            }
            TOT[sq * 128 + d] = run;
        }
        __syncthreads();
        {
            const float t0 = TOT[d], t1 = TOT[128 + d], t2 = TOT[256 + d], t3 = TOT[384 + d];
            float pre[4];
            if (dir == 0) { pre[0] = 0.f; pre[1] = t0; pre[2] = t0 + t1; pre[3] = t0 + t1 + t2; }
            else          { pre[3] = 0.f; pre[2] = t3; pre[1] = t3 + t2; pre[0] = t3 + t2 + t1; }
            if (tid < 128) { const float dec = __expf(t0 + t1 + t2 + t3); DECS[d] = dec; DEC[((size_t)((dir * 8 + b * 4 + h) * 128 + c)) * 128 + d] = dec; }
#pragma unroll
            for (int i = 0; i < 16; ++i) {
                const int s = sq + 4 * i;
                const float bb = LF[s * 128 + d] + pre[i >> 2];
                const float eq = __expf(bb), ek = __expf(-bb);
                const float qv = bf2f(QS[s * 128 + d]);
                const bf16_t qt = (bf16_t)f2bf(qv * eq), kp = (bf16_t)f2bf(kreg[i] * ek);
                QT[s * OHG_QP + d] = qt; KP[s * OHG_QP + d] = kp; KPT[d * OHG_VP + s] = kp;
            }
        }
        __syncthreads();
        {
            f32x4 aT[4];
#pragma unroll
            for (int st = 0; st < 4; ++st) {
                f32x4 acc = {0.f, 0.f, 0.f, 0.f};
                const bool live = dir ? (st >= tt) : (st <= tt);
                if (live) {
#pragma unroll
                    for (int ks = 0; ks < 4; ++ks) {
                        const bf16x8 af = *(const LAS bf16x8*)(KP + (16 * st + fr) * OHG_QP + 32 * ks + 8 * g);
                        const bf16x8 bfr = *(const LAS bf16x8*)(QT + (16 * tt + fr) * OHG_QP + 32 * ks + 8 * g);
                        acc = __builtin_amdgcn_mfma_f32_16x16x32_bf16(af, bfr, acc, 0, 0, 0);
                    }
                    const int t = 16 * tt + fr;
#pragma unroll
                    for (int rg = 0; rg < 4; ++rg) { const int s = 16 * st + 4 * g + rg; const bool keep = dir ? (s >= t) : (s <= t); acc[rg] = keep ? acc[rg] : 0.f; }
                }
                aT[st] = acc;
            }
#pragma unroll
            for (int kk = 0; kk < 2; ++kk) {
                u32x4 aw; aw.x = pk2(aT[2 * kk][0], aT[2 * kk][1]); aw.y = pk2(aT[2 * kk][2], aT[2 * kk][3]);
                aw.z = pk2(aT[2 * kk + 1][0], aT[2 * kk + 1][1]); aw.w = pk2(aT[2 * kk + 1][2], aT[2 * kk + 1][3]);
                const bf16x8 af = as_bf16x8(aw);
#pragma unroll
                for (int nt = 0; nt < 4; ++nt) {
                    const LAS bf16_t* vp = VT + (64 * eh + 16 * nt + fr) * OHG_VP + 32 * kk + 4 * g;
                    const u32x2 lo = *(const LAS u32x2*)(vp), hi = *(const LAS u32x2*)(vp + 16);
                    u32x4 vw; vw.x = lo.x; vw.y = lo.y; vw.z = hi.x; vw.w = hi.y;
                    OI[nt] = __builtin_amdgcn_mfma_f32_16x16x32_bf16(af, as_bf16x8(vw), OI[nt], 0, 0, 0);
                }
            }
        }
        {
            const bf16x8 va0 = *(const LAS bf16x8*)(VT + (16 * w + fr) * OHG_VP + 8 * g), va1 = *(const LAS bf16x8*)(VT + (16 * w + fr) * OHG_VP + 32 + 8 * g);
            bf16_t* up = US + ((size_t)((dir * 8 + b * 4 + h) * 128 + c)) * 16384;
#pragma unroll
            for (int dt = 0; dt < 8; ++dt) {
                const bf16x8 kb0 = *(const LAS bf16x8*)(KPT + (16 * dt + fr) * OHG_VP + 8 * g), kb1 = *(const LAS bf16x8*)(KPT + (16 * dt + fr) * OHG_VP + 32 + 8 * g);
                f32x4 acc = {0.f, 0.f, 0.f, 0.f};
                acc = __builtin_amdgcn_mfma_f32_16x16x32_bf16(va0, kb0, acc, 0, 0, 0);
                acc = __builtin_amdgcn_mfma_f32_16x16x32_bf16(va1, kb1, acc, 0, 0, 0);
                const float dec = DECS[16 * dt + fr];
#pragma unroll
                for (int rg = 0; rg < 4; ++rg) up[(16 * w + 4 * g + rg) * 128 + 16 * dt + fr] = (bf16_t)f2bf(acc[rg] * dec);
            }
        }
#pragma unroll
        for (int i = 0; i < 2; ++i) {
            const int p = tid + i * NTHREADS, s = p >> 4, d8 = (p & 15) * 8;
            *(u32x4*)(H + (tok0 + s) * DIN + zc + h * 128 + d8) = *(const LAS u32x4*)(QT + s * OHG_QP + d8);
        }
        __syncthreads();
    }
#pragma unroll
    for (int nt = 0; nt < 4; ++nt)
#pragma unroll
        for (int rg = 0; rg < 4; ++rg)
            H[(tok0 + 16 * tt + 4 * g + rg) * DIN + C_QH + h * 128 + 64 * eh + 16 * nt + fr] = (bf16_t)f2bf(OI[nt][rg]);
}

#endif
constexpr int HG_QS = 0, HG_VT = 16384, HG_ZQ = 34816, HG_KP = 69632, HG_KPT = 104448, HG_TOT = 141312, HG_DECS = 143360;
constexpr int HG_VP = 72, HG_QP = 136;
constexpr int HG_DIRQ = 64 * HG_QP, HG_DIRT = 128 * HG_VP;
struct HgPre { u32x4 q[2], v[2], zf[2], zb[2]; };
__device__ __forceinline__ void hg_prefetch(HgPre& P, const bf16_t* H, int ht) {
    const int tid = threadIdx.x, b = ht >> 9, h = (ht >> 7) & 3, c = ht & 127;
    const size_t tok0 = (size_t)b * SEQ + (size_t)c * 64;
#pragma unroll
    for (int i = 0; i < 2; ++i) {
        const int p = tid + i * NTHREADS, s = p >> 4, d8 = (p & 15) * 8;
        const bf16_t* rowp = H + (tok0 + s) * DIN + h * 128 + d8;
        P.q[i] = *(const u32x4*)(rowp + C_QH); P.v[i] = *(const u32x4*)(rowp + C_IH); P.zf[i] = *(const u32x4*)(rowp + C_ZF); P.zb[i] = *(const u32x4*)(rowp + C_ZB);
    }
}
template <int DIRV> __device__ __forceinline__ void hg_s1(const LAS bf16_t* ZQd, LAS float* TOTd, float lb, int hf, int d, float (&cum)[32], float (&kk_)[32]) {
    const LAS bf16_t* zp = ZQd + (32 * hf) * HG_QP + d;
    float run = 0.f;
#pragma unroll
    for (int i = 0; i < 32; ++i) {
        const float z = bf2f(zp[(DIRV ? (31 - i) : i) * HG_QP]);
        const float ez = __expf(-z), sg = __builtin_amdgcn_rcpf(1.f + ez);
        const float f = lb + (1.f - lb) * sg;
        run += __logf(f); cum[i] = run; kk_[i] = (1.f - lb) * (1.f - sg);
    }
    TOTd[hf * 128 + d] = run;
}
template <int DIRV> __device__ __forceinline__ void hg_s2(const LAS bf16_t* QS, LAS bf16_t* ZQd, LAS bf16_t* KPd, LAS bf16_t* KPTd, float pre, int hf, int d, const float (&cum)[32], const float (&kk_)[32]) {
    const LAS bf16_t* qp = QS + (32 * hf) * 128 + d;
    LAS bf16_t* zq = ZQd + (32 * hf) * HG_QP + d; LAS bf16_t* kp = KPd + (32 * hf) * HG_QP + d; LAS bf16_t* kt = KPTd + d * HG_VP + 32 * hf;
#pragma unroll
    for (int i = 0; i < 32; i += 2) {
        const int sA = DIRV ? (31 - i) : i, sB = DIRV ? (sA - 1) : (sA + 1);
        const float bA = cum[i] + pre, bB = cum[i + 1] + pre;
        const float qA = bf2f(qp[sA * 128]), qB = bf2f(qp[sB * 128]);
        const unsigned qtA = f2bf(qA * __expf(bA)), qtB = f2bf(qB * __expf(bB));
        const unsigned kpA = f2bf(kk_[i] * __expf(-bA)), kpB = f2bf(kk_[i + 1] * __expf(-bB));
        zq[sA * HG_QP] = (bf16_t)qtA; zq[sB * HG_QP] = (bf16_t)qtB;
        kp[sA * HG_QP] = (bf16_t)kpA; kp[sB * HG_QP] = (bf16_t)kpB;
        *(LAS unsigned*)(kt + (DIRV ? sB : sA)) = DIRV ? (kpB | (kpA << 16)) : (kpA | (kpB << 16));
    }
}
__device__ __forceinline__ void hgrn_local_phase(LAS unsigned char* lds, bf16_t* H, const float* lbf, const float* lbb, bf16_t* US, float* DEC, int bx, int G) {
    const int tid = threadIdx.x, lane = tid & 63, w = tid >> 6, fr = lane & 15, g = lane >> 4;
    LAS bf16_t* QS = (LAS bf16_t*)(lds + HG_QS); LAS bf16_t* VT = (LAS bf16_t*)(lds + HG_VT); LAS bf16_t* ZQ = (LAS bf16_t*)(lds + HG_ZQ);
    LAS bf16_t* KP = (LAS bf16_t*)(lds + HG_KP); LAS bf16_t* KPT = (LAS bf16_t*)(lds + HG_KPT); LAS float* TOT = (LAS float*)(lds + HG_TOT); LAS float* DECS = (LAS float*)(lds + HG_DECS);
    if (bx >= 1024) return;
    HgPre P; hg_prefetch(P, H, bx);
    const int d = tid & 127, hf = (tid >> 7) & 1, edir = tid >> 8;
    for (int ht = bx; ht < 1024; ht += G) {
        const int b = ht >> 9, h = (ht >> 7) & 3, c = ht & 127;
        const size_t tok0 = (size_t)b * SEQ + (size_t)c * 64;
#ifdef HG_NOPF
        if (ht != bx) hg_prefetch(P, H, ht);
#endif
#pragma unroll
        for (int i = 0; i < 2; ++i) {
            const int p = tid + i * NTHREADS, s = p >> 4, d8 = (p & 15) * 8;
            *(LAS u32x4*)(QS + s * 128 + d8) = P.q[i];
            *(LAS u32x4*)(ZQ + s * HG_QP + d8) = P.zf[i];
            *(LAS u32x4*)(ZQ + HG_DIRQ + s * HG_QP + d8) = P.zb[i];
#pragma unroll
            for (int k = 0; k < 4; ++k) { VT[(d8 + 2 * k) * HG_VP + s] = (bf16_t)(P.v[i][k] & 0xffffu); VT[(d8 + 2 * k + 1) * HG_VP + s] = (bf16_t)(P.v[i][k] >> 16); }
        }
        __syncthreads();
#ifndef HG_NOPF
        if (ht + G < 1024) hg_prefetch(P, H, ht + G);
#endif
        const float* lbl = edir ? lbb : lbf;
        const float lb = 1.f / (1.f + __expf(lbl[512 + h * 128 + d] - lbl[h * 128 + d]));
        float cum[32], kk_[32];
        if (edir == 0) hg_s1<0>(ZQ, TOT, lb, hf, d, cum, kk_); else hg_s1<1>(ZQ + HG_DIRQ, TOT + 256, lb, hf, d, cum, kk_);
        __syncthreads();
        {
            const float t0 = TOT[(edir * 2) * 128 + d], t1 = TOT[(edir * 2 + 1) * 128 + d];
            const float pre = edir ? (hf ? 0.f : t1) : (hf ? t0 : 0.f);
            if (hf == 0) { const float dec = __expf(t0 + t1); DECS[edir * 128 + d] = dec; DEC[((size_t)((edir * 8 + b * 4 + h) * 128 + c)) * 128 + d] = dec; }
            if (edir == 0) hg_s2<0>(QS, ZQ, KP, KPT, pre, hf, d, cum, kk_); else hg_s2<1>(QS, ZQ + HG_DIRQ, KP + HG_DIRQ, KPT + HG_DIRT, pre, hf, d, cum, kk_);
        }
        __syncthreads();
#ifdef HG_OLDS3
        {
            const int tt = w & 3, eh = w >> 2;
            f32x4 OI[4];
#pragma unroll
            for (int nt = 0; nt < 4; ++nt) OI[nt] = (f32x4){0.f, 0.f, 0.f, 0.f};
#pragma unroll
            for (int dir = 0; dir < 2; ++dir) {
                const LAS bf16_t* QTd = ZQ + dir * HG_DIRQ; const LAS bf16_t* KPd = KP + dir * HG_DIRQ; const LAS bf16_t* KPTd = KPT + dir * HG_DIRT;
                f32x4 aT[4];
#pragma unroll
                for (int st = 0; st < 4; ++st) {
                    f32x4 acc = {0.f, 0.f, 0.f, 0.f};
                    const bool live = dir ? (st >= tt) : (st <= tt);
                    if (live) {
#pragma unroll
                        for (int ks = 0; ks < 4; ++ks) {
                            const bf16x8 af = *(const LAS bf16x8*)(KPd + (16 * st + fr) * HG_QP + 32 * ks + 8 * g);
                            const bf16x8 bfr = *(const LAS bf16x8*)(QTd + (16 * tt + fr) * HG_QP + 32 * ks + 8 * g);
                            acc = __builtin_amdgcn_mfma_f32_16x16x32_bf16(af, bfr, acc, 0, 0, 0);
                        }
                        const int t = 16 * tt + fr;
#pragma unroll
                        for (int rg = 0; rg < 4; ++rg) { const int s = 16 * st + 4 * g + rg; const bool keep = dir ? (s >= t) : (s <= t); acc[rg] = keep ? acc[rg] : 0.f; }
                    }
                    aT[st] = acc;
                }
#pragma unroll
                for (int kk = 0; kk < 2; ++kk) {
                    u32x4 aw; aw.x = pk2(aT[2 * kk][0], aT[2 * kk][1]); aw.y = pk2(aT[2 * kk][2], aT[2 * kk][3]);
                    aw.z = pk2(aT[2 * kk + 1][0], aT[2 * kk + 1][1]); aw.w = pk2(aT[2 * kk + 1][2], aT[2 * kk + 1][3]);
                    const bf16x8 af = as_bf16x8(aw);
#pragma unroll
                    for (int nt = 0; nt < 4; ++nt) {
                        const LAS bf16_t* vp = VT + (64 * eh + 16 * nt + fr) * HG_VP + 32 * kk + 4 * g;
                        const u32x2 lo = *(const LAS u32x2*)(vp), hi = *(const LAS u32x2*)(vp + 16);
                        u32x4 vw; vw.x = lo.x; vw.y = lo.y; vw.z = hi.x; vw.w = hi.y;
                        OI[nt] = __builtin_amdgcn_mfma_f32_16x16x32_bf16(af, as_bf16x8(vw), OI[nt], 0, 0, 0);
                    }
                }
#ifndef HG_NEWS3B
                {
                    const bf16x8 va0 = *(const LAS bf16x8*)(VT + (16 * w + fr) * HG_VP + 8 * g), va1 = *(const LAS bf16x8*)(VT + (16 * w + fr) * HG_VP + 32 + 8 * g);
                    bf16_t* up = US + ((size_t)((dir * 8 + b * 4 + h) * 128 + c)) * 16384;
#pragma unroll
                    for (int dt = 0; dt < 8; ++dt) {
                        const bf16x8 kb0 = *(const LAS bf16x8*)(KPTd + (16 * dt + fr) * HG_VP + 8 * g), kb1 = *(const LAS bf16x8*)(KPTd + (16 * dt + fr) * HG_VP + 32 + 8 * g);
                        f32x4 acc = {0.f, 0.f, 0.f, 0.f};
                        acc = __builtin_amdgcn_mfma_f32_16x16x32_bf16(va0, kb0, acc, 0, 0, 0);
                        acc = __builtin_amdgcn_mfma_f32_16x16x32_bf16(va1, kb1, acc, 0, 0, 0);
                        const float dec = DECS[dir * 128 + 16 * dt + fr];
#pragma unroll
                        for (int rg = 0; rg < 4; ++rg) up[(16 * w + 4 * g + rg) * 128 + 16 * dt + fr] = (bf16_t)f2bf(acc[rg] * dec);
                    }
                }
#endif
            }
#pragma unroll
            for (int nt = 0; nt < 4; ++nt)
#pragma unroll
                for (int rg = 0; rg < 4; ++rg)
                    H[(tok0 + 16 * tt + 4 * g + rg) * DIN + C_QH + h * 128 + 64 * eh + 16 * nt + fr] = (bf16_t)f2bf(OI[nt][rg]);
        }
#ifdef HG_NEWS3B
        {
            const int dir = w >> 2, ep = w & 3;
            bf16x8 vb[2][2];
#pragma unroll
            for (int j = 0; j < 2; ++j)
#pragma unroll
                for (int ks = 0; ks < 2; ++ks) vb[j][ks] = *(const LAS bf16x8*)(VT + (32 * ep + 16 * j + fr) * HG_VP + 32 * ks + 8 * g);
            bf16_t* up = US + ((size_t)((dir * 8 + b * 4 + h) * 128 + c)) * 16384;
#pragma unroll
            for (int dt = 0; dt < 8; ++dt) {
                const bf16x8 ka0 = *(const LAS bf16x8*)(KPT + dir * HG_DIRT + (16 * dt + fr) * HG_VP + 8 * g), ka1 = *(const LAS bf16x8*)(KPT + dir * HG_DIRT + (16 * dt + fr) * HG_VP + 32 + 8 * g);
                const f32x4 dec = *(const LAS f32x4*)(DECS + dir * 128 + 16 * dt + 4 * g);
#pragma unroll
                for (int j = 0; j < 2; ++j) {
                    f32x4 acc = {0.f, 0.f, 0.f, 0.f};
                    acc = __builtin_amdgcn_mfma_f32_16x16x32_bf16(ka0, vb[j][0], acc, 0, 0, 0);
                    acc = __builtin_amdgcn_mfma_f32_16x16x32_bf16(ka1, vb[j][1], acc, 0, 0, 0);
                    acc = acc * dec;
                    u32x2 ow; ow.x = pk2(acc[0], acc[1]); ow.y = pk2(acc[2], acc[3]);
                    *(u32x2*)(up + (32 * ep + 16 * j + fr) * 128 + 16 * dt + 4 * g) = ow;
                }
            }
        }
#endif
#else
        {
            const int tt = w & 3, eh = w >> 2;
            f32x4 OI[4];
#pragma unroll
            for (int et = 0; et < 4; ++et) OI[et] = (f32x4){0.f, 0.f, 0.f, 0.f};
#pragma unroll
            for (int dir = 0; dir < 2; ++dir) {
                f32x4 aT[4];
#pragma unroll
                for (int st = 0; st < 4; ++st) {
                    f32x4 acc = {0.f, 0.f, 0.f, 0.f};
                    const bool live = dir ? (st >= tt) : (st <= tt);
                    if (live) {
#pragma unroll
                        for (int ks = 0; ks < 4; ++ks) {
                            const bf16x8 af = *(const LAS bf16x8*)(KP + dir * HG_DIRQ + (16 * st + fr) * HG_QP + 32 * ks + 8 * g);
                            const bf16x8 bfr = *(const LAS bf16x8*)(ZQ + dir * HG_DIRQ + (16 * tt + fr) * HG_QP + 32 * ks + 8 * g);
                            acc = __builtin_amdgcn_mfma_f32_16x16x32_bf16(af, bfr, acc, 0, 0, 0);
                        }
                        const int t = 16 * tt + fr;
#pragma unroll
                        for (int rg = 0; rg < 4; ++rg) { const int s = 16 * st + 4 * g + rg; const bool keep = dir ? (s >= t) : (s <= t); acc[rg] = keep ? acc[rg] : 0.f; }
                    }
                    aT[st] = acc;
                }
#pragma unroll
                for (int kk = 0; kk < 2; ++kk) {
                    u32x4 aw; aw.x = pk2(aT[2 * kk][0], aT[2 * kk][1]); aw.y = pk2(aT[2 * kk][2], aT[2 * kk][3]);
                    aw.z = pk2(aT[2 * kk + 1][0], aT[2 * kk + 1][1]); aw.w = pk2(aT[2 * kk + 1][2], aT[2 * kk + 1][3]);
                    const bf16x8 pb = as_bf16x8(aw);
#pragma unroll
                    for (int et = 0; et < 4; ++et) {
                        const LAS bf16_t* vp = VT + (64 * eh + 16 * et + fr) * HG_VP + 32 * kk + 4 * g;
                        const u32x2 lo = *(const LAS u32x2*)(vp), hi = *(const LAS u32x2*)(vp + 16);
                        u32x4 vw; vw.x = lo.x; vw.y = lo.y; vw.z = hi.x; vw.w = hi.y;
                        OI[et] = __builtin_amdgcn_mfma_f32_16x16x32_bf16(as_bf16x8(vw), pb, OI[et], 0, 0, 0);
                    }
                }
            }
#pragma unroll
            for (int et = 0; et < 4; ++et) {
                u32x2 ow; ow.x = pk2(OI[et][0], OI[et][1]); ow.y = pk2(OI[et][2], OI[et][3]);
                *(u32x2*)(H + (tok0 + 16 * tt + fr) * DIN + C_QH + h * 128 + 64 * eh + 16 * et + 4 * g) = ow;
            }
        }
        {
            const int dir = w >> 2, ep = w & 3;
            bf16x8 vb[2][2];
#pragma unroll
            for (int j = 0; j < 2; ++j)
#pragma unroll
                for (int ks = 0; ks < 2; ++ks) vb[j][ks] = *(const LAS bf16x8*)(VT + (32 * ep + 16 * j + fr) * HG_VP + 32 * ks + 8 * g);
            bf16_t* up = US + ((size_t)((dir * 8 + b * 4 + h) * 128 + c)) * 16384;
#pragma unroll
            for (int dt = 0; dt < 8; ++dt) {
                const bf16x8 ka0 = *(const LAS bf16x8*)(KPT + dir * HG_DIRT + (16 * dt + fr) * HG_VP + 8 * g), ka1 = *(const LAS bf16x8*)(KPT + dir * HG_DIRT + (16 * dt + fr) * HG_VP + 32 + 8 * g);
                const f32x4 dec = *(const LAS f32x4*)(DECS + dir * 128 + 16 * dt + 4 * g);
#pragma unroll
                for (int j = 0; j < 2; ++j) {
                    f32x4 acc = {0.f, 0.f, 0.f, 0.f};
                    acc = __builtin_amdgcn_mfma_f32_16x16x32_bf16(ka0, vb[j][0], acc, 0, 0, 0);
                    acc = __builtin_amdgcn_mfma_f32_16x16x32_bf16(ka1, vb[j][1], acc, 0, 0, 0);
                    acc = acc * dec;
                    u32x2 ow; ow.x = pk2(acc[0], acc[1]); ow.y = pk2(acc[2], acc[3]);
                    *(u32x2*)(up + (32 * ep + 16 * j + fr) * 128 + 16 * dt + 4 * g) = ow;
                }
            }
        }
#endif
#pragma unroll
        for (int i = 0; i < 4; ++i) {
            const int p = tid + i * NTHREADS, dir = p >> 10, pp = p & 1023, s = pp >> 4, d8 = (pp & 15) * 8;
            *(u32x4*)(H + (tok0 + s) * DIN + (dir ? C_ZB : C_ZF) + h * 128 + d8) = *(const LAS u32x4*)(ZQ + dir * HG_DIRQ + s * HG_QP + d8);
        }
        __syncthreads();
    }
}

__device__ __forceinline__ void hgrn_state_scan(bf16_t* US, const float* DEC, int dry) {
    if (threadIdx.x >= 256) return;
    const int gt = blockIdx.x * 256 + threadIdx.x, GT = gridDim.x * 256;
    for (int it = gt; it < 16 * 4096; it += GT) {
        const int sidx = it >> 12, rem = (it & 4095) * 4, d = rem & 127, dir = sidx >> 3;
        f32x4 st = {0.f, 0.f, 0.f, 0.f};
        for (int c0 = 0; c0 < 128; c0 += 8) {
            u32x2 u[8]; f32x4 dc[8];
#pragma unroll
            for (int k = 0; k < 8; ++k) {
                const int c = dir ? (127 - c0 - k) : (c0 + k);
                u[k] = *(const u32x2*)(US + ((size_t)(sidx * 128 + c)) * 16384 + rem);
                dc[k] = *(const f32x4*)(DEC + ((size_t)(sidx * 128 + c)) * 128 + d);
            }
#pragma unroll
            for (int k = 0; k < 8; ++k) {
                const int c = dir ? (127 - c0 - k) : (c0 + k);
                u32x2 o; o.x = pk2(st[0], st[1]); o.y = pk2(st[2], st[3]);
                *(u32x2*)(US + ((size_t)(sidx * 128 + c)) * 16384 + rem) = dry ? u[k] : o;
                const f32x4 uv = {bf2f(u[k].x & 0xffffu), bf2f(u[k].x >> 16), bf2f(u[k].y & 0xffffu), bf2f(u[k].y >> 16)};
                st = dc[k] * st + uv;
            }
        }
    }
}

__device__ __forceinline__ void hgrn_out_phase(const bf16_t* H, const bf16_t* US, const float* gain, bf16_t* CAT, int bx, int G) {
    const int tid = threadIdx.x, lane = tid & 63, w = tid >> 6, fr = lane & 15, g = lane >> 4;
    for (int item = bx * 8 + w; item < 2048; item += G * 8) {
        const int ht = item >> 1, tp = item & 1;
        const int b = ht >> 9, h = (ht >> 7) & 3, c = ht & 127;
        const size_t tok0 = (size_t)b * SEQ + (size_t)c * 64 + 32 * tp;
        f32x4 acc[2][8];
#pragma unroll
        for (int j = 0; j < 2; ++j)
#pragma unroll
            for (int et = 0; et < 8; ++et) acc[j][et] = (f32x4){0.f, 0.f, 0.f, 0.f};
        {
            const bf16_t* sp0 = US + ((size_t)((0 * 8 + b * 4 + h) * 128 + c)) * 16384 + 8 * g + fr * 128;
            const bf16_t* sp1 = US + ((size_t)((1 * 8 + b * 4 + h) * 128 + c)) * 16384 + 8 * g + fr * 128;
            const bf16_t* qp = H + (tok0 + fr) * DIN + h * 128 + 8 * g;
            bf16x8 qb[2][4], cur[8], nxt[8];
#pragma unroll
            for (int j = 0; j < 2; ++j)
#pragma unroll
                for (int ks = 0; ks < 4; ++ks) qb[j][ks] = as_bf16x8(*(const u32x4*)(qp + (size_t)(16 * j) * DIN + C_ZF + 32 * ks));
#pragma unroll
            for (int i = 0; i < 8; ++i) cur[i] = as_bf16x8(*(const u32x4*)(sp0 + (16 * (i >> 2)) * 128 + 32 * (i & 3)));
#pragma unroll
            for (int p = 0; p < 8; ++p) {
                const int et2 = p & 3;
                if (p + 1 < 8) { const bf16_t* spn = ((p + 1) >> 2) ? sp1 : sp0; const int e2n = (p + 1) & 3;
#pragma unroll
                    for (int i = 0; i < 8; ++i) nxt[i] = as_bf16x8(*(const u32x4*)(spn + (16 * (2 * e2n + (i >> 2))) * 128 + 32 * (i & 3))); }
#pragma unroll
                for (int e = 0; e < 2; ++e)
#pragma unroll
                    for (int ks = 0; ks < 4; ++ks) {
                        acc[0][2 * et2 + e] = __builtin_amdgcn_mfma_f32_16x16x32_bf16(cur[e * 4 + ks], qb[0][ks], acc[0][2 * et2 + e], 0, 0, 0);
                        acc[1][2 * et2 + e] = __builtin_amdgcn_mfma_f32_16x16x32_bf16(cur[e * 4 + ks], qb[1][ks], acc[1][2 * et2 + e], 0, 0, 0);
                    }
                if (p == 3) {
#pragma unroll
                    for (int j = 0; j < 2; ++j)
#pragma unroll
                        for (int ks = 0; ks < 4; ++ks) qb[j][ks] = as_bf16x8(*(const u32x4*)(qp + (size_t)(16 * j) * DIN + C_ZB + 32 * ks));
                }
                __builtin_amdgcn_sched_barrier(0);
#pragma unroll
                for (int i = 0; i < 8; ++i) cur[i] = nxt[i];
            }
        }
#pragma unroll
        for (int j = 0; j < 2; ++j) {
            const bf16_t* hrow = H + (tok0 + 16 * j + fr) * DIN + h * 128 + 4 * g;
            float ssq = 0.f;
#pragma unroll
            for (int et = 0; et < 8; ++et) {
                const u32x2 oi = *(const u32x2*)(hrow + C_QH + 16 * et);
                acc[j][et][0] += bf2f(oi.x & 0xffffu); acc[j][et][1] += bf2f(oi.x >> 16); acc[j][et][2] += bf2f(oi.y & 0xffffu); acc[j][et][3] += bf2f(oi.y >> 16);
                ssq += acc[j][et][0] * acc[j][et][0] + acc[j][et][1] * acc[j][et][1] + acc[j][et][2] * acc[j][et][2] + acc[j][et][3] * acc[j][et][3];
            }
            ssq += __shfl_xor(ssq, 16); ssq += __shfl_xor(ssq, 32);
            const float rsn = rsqrtf(ssq * (1.f / 128.f) + 1e-6f);
#pragma unroll
            for (int et = 0; et < 8; ++et) {
                const u32x2 gw = *(const u32x2*)(hrow + C_GH + 16 * et);
                const f32x4 gn = *(const f32x4*)(gain + h * 128 + 16 * et + 4 * g);
                const float g0 = bf2f(gw.x & 0xffffu), g1 = bf2f(gw.x >> 16), g2 = bf2f(gw.y & 0xffffu), g3 = bf2f(gw.y >> 16);
                u32x2 ow; ow.x = pk2(acc[j][et][0] * rsn * gn[0] * siluf_(g0), acc[j][et][1] * rsn * gn[1] * siluf_(g1));
                ow.y = pk2(acc[j][et][2] * rsn * gn[2] * siluf_(g2), acc[j][et][3] * rsn * gn[3] * siluf_(g3));
                *(u32x2*)(CAT + (tok0 + 16 * j + fr) * DM + 512 + h * 128 + 16 * et + 4 * g) = ow;
            }
        }
    }
}

#ifdef OLD_P4
__device__ __forceinline__ void hgrn_out_tile(LAS unsigned char* lds, const bf16_t* H, const bf16_t* US, const float* gain, bf16_t* CAT, int ht) {
    const int tid = threadIdx.x, lane = tid & 63, w = tid >> 6, fr = lane & 15, g = lane >> 4;
    const int b = ht >> 9, h = (ht >> 7) & 3, c = ht & 127;
    const size_t tok0 = (size_t)b * SEQ + (size_t)c * 64;
    const int tt = w & 3, eh = w >> 2;
    LAS float* SSQ = (LAS float*)lds;
    f32x4 acc[4];
#pragma unroll
    for (int nt = 0; nt < 4; ++nt) acc[nt] = (f32x4){0.f, 0.f, 0.f, 0.f};
#pragma unroll
    for (int dir = 0; dir < 2; ++dir) {
        const bf16_t* qp = H + (tok0 + 16 * tt + fr) * DIN + (dir ? C_ZB : C_ZF) + h * 128 + 8 * g;
        const bf16_t* sp = US + ((size_t)((dir * 8 + b * 4 + h) * 128 + c)) * 16384 + 8 * g;
        bf16x8 qa[4];
#pragma unroll
        for (int ks = 0; ks < 4; ++ks) qa[ks] = as_bf16x8(*(const u32x4*)(qp + 32 * ks));
#pragma unroll
        for (int nt = 0; nt < 4; ++nt)
#pragma unroll
            for (int ks = 0; ks < 4; ++ks) {
                const bf16x8 sb = as_bf16x8(*(const u32x4*)(sp + (64 * eh + 16 * nt + fr) * 128 + 32 * ks));
                acc[nt] = __builtin_amdgcn_mfma_f32_16x16x32_bf16(qa[ks], sb, acc[nt], 0, 0, 0);
            }
    }
    float ssq[4] = {0.f, 0.f, 0.f, 0.f};
#pragma unroll
    for (int nt = 0; nt < 4; ++nt)
#pragma unroll
        for (int rg = 0; rg < 4; ++rg) {
            acc[nt][rg] += bf2f(H[(tok0 + 16 * tt + 4 * g + rg) * DIN + C_QH + h * 128 + 64 * eh + 16 * nt + fr]);
            ssq[rg] += acc[nt][rg] * acc[nt][rg];
        }
#pragma unroll
    for (int rg = 0; rg < 4; ++rg) {
        float v = ssq[rg];
        v += __shfl_xor(v, 1); v += __shfl_xor(v, 2); v += __shfl_xor(v, 4); v += __shfl_xor(v, 8);
        ssq[rg] = v;
    }
    if (fr == 0) {
#pragma unroll
        for (int rg = 0; rg < 4; ++rg) SSQ[eh * 64 + 16 * tt + 4 * g + rg] = ssq[rg];
    }
    __syncthreads();
#pragma unroll
    for (int rg = 0; rg < 4; ++rg) {
        const int t = 16 * tt + 4 * g + rg;
        const float rsn = rsqrtf((SSQ[t] + SSQ[64 + t]) * (1.f / 128.f) + 1e-6f);
#pragma unroll
        for (int nt = 0; nt < 4; ++nt) {
            const int e = h * 128 + 64 * eh + 16 * nt + fr;
            const float gh = bf2f(H[(tok0 + t) * DIN + C_GH + e]);
            CAT[(tok0 + t) * DM + 512 + e] = (bf16_t)f2bf(acc[nt][rg] * rsn * gain[e] * siluf_(gh));
        }
    }
    __syncthreads();
}

#endif
#ifdef OLD_P3
__device__ __forceinline__ void hgrn_state_scan_old(bf16_t* US, const float* DEC, int dry) {
    const int gt = blockIdx.x * NTHREADS + threadIdx.x, GT = gridDim.x * NTHREADS;
    for (int it = gt; it < 16 * 8192; it += GT) {
        const int sidx = it >> 13, rem = (it & 8191) * 2, d = rem & 127, dir = sidx >> 3;
        float s0 = 0.f, s1 = 0.f;
        for (int c0 = 0; c0 < 128; c0 += 8) {
            unsigned u[8]; float2 dc[8];
#pragma unroll
            for (int k = 0; k < 8; ++k) {
                const int c = dir ? (127 - c0 - k) : (c0 + k);
                u[k] = *(const unsigned*)(US + ((size_t)(sidx * 128 + c)) * 16384 + rem);
                dc[k] = *(const float2*)(DEC + ((size_t)(sidx * 128 + c)) * 128 + d);
            }
#pragma unroll
            for (int k = 0; k < 8; ++k) {
                const int c = dir ? (127 - c0 - k) : (c0 + k);
                *(unsigned*)(US + ((size_t)(sidx * 128 + c)) * 16384 + rem) = dry ? u[k] : pk2(s0, s1);
                s0 = dc[k].x * s0 + bf2f(u[k] & 0xffffu); s1 = dc[k].y * s1 + bf2f(u[k] >> 16);
            }
        }
    }
}

#endif
__device__ __forceinline__ void ln_rows(const float* R, const float* gain, const float* bias, float* out) {
    const int lane = threadIdx.x & 63, gw = blockIdx.x * 8 + (threadIdx.x >> 6), GW = gridDim.x * 8;
    f32x4 gv[4], bv[4];
#pragma unroll
    for (int i = 0; i < 4; ++i) { gv[i] = *(const f32x4*)(gain + i * 256 + lane * 4); bv[i] = *(const f32x4*)(bias + i * 256 + lane * 4); }
    for (int row0 = gw * 4; row0 < MROWS; row0 += GW * 4) {
        f32x4 v[4][4]; float s[4], q[4];
#pragma unroll
        for (int r = 0; r < 4; ++r)
#pragma unroll
            for (int i = 0; i < 4; ++i) v[r][i] = *(const f32x4*)(R + (size_t)(row0 + r) * DM + i * 256 + lane * 4);
#pragma unroll
        for (int r = 0; r < 4; ++r) { s[r] = 0.f;
#pragma unroll
            for (int i = 0; i < 4; ++i) s[r] += v[r][i][0] + v[r][i][1] + v[r][i][2] + v[r][i][3]; }
#pragma unroll
        for (int o = 1; o < 64; o <<= 1)
#pragma unroll
            for (int r = 0; r < 4; ++r) s[r] += __shfl_xor(s[r], o);
#pragma unroll
        for (int r = 0; r < 4; ++r) { const float mu = s[r] * (1.f / 1024.f); q[r] = 0.f;
#pragma unroll
            for (int i = 0; i < 4; ++i) { v[r][i] = v[r][i] - mu; q[r] += v[r][i][0] * v[r][i][0] + v[r][i][1] * v[r][i][1] + v[r][i][2] * v[r][i][2] + v[r][i][3] * v[r][i][3]; } }
#pragma unroll
        for (int o = 1; o < 64; o <<= 1)
#pragma unroll
            for (int r = 0; r < 4; ++r) q[r] += __shfl_xor(q[r], o);
#pragma unroll
        for (int r = 0; r < 4; ++r) { const float rsd = rsqrtf(q[r] * (1.f / 1024.f) + 1e-5f);
#pragma unroll
            for (int i = 0; i < 4; ++i) __builtin_nontemporal_store(v[r][i] * rsd * gv[i] + bv[i], (f32x4*)(out + (size_t)(row0 + r) * DM + i * 256 + lane * 4)); }
    }
}

#define XB_TMO      128
#define XB_XCNT(j)  (256  + 64 * (j))
#define XB_XSUB(j)  (1280 + 64 * (j))
#define XB_XGEN(j)  (2304 + 64 * (j))
#define XB_TOP      3328
#define XB_TOPGEN   3392
#define XCD_BAR_WORDS 3456
#define XB_SPIN_CAP (1u << 18)
__device__ __forceinline__ unsigned xb_ld(unsigned* p)              { return __hip_atomic_load(p, __ATOMIC_RELAXED, __HIP_MEMORY_SCOPE_AGENT); }
__device__ __forceinline__ unsigned xb_add(unsigned* p, unsigned v) { return __hip_atomic_fetch_add(p, v, __ATOMIC_RELAXED, __HIP_MEMORY_SCOPE_AGENT); }
__device__ __forceinline__ unsigned xb_xcc_id() { return (unsigned)__builtin_amdgcn_s_getreg((3 << 11) | 20) & 0xFu; }
#define XB_SPIN(cond, bar) do { unsigned _sp = 0; while (cond) { __builtin_amdgcn_s_sleep(1); \
    if ((++_sp & 255u) == 0u) { if (xb_ld(&(bar)[XB_TMO])) break; if (_sp > XB_SPIN_CAP) { atomicAdd(&(bar)[XB_TMO], 1u); break; } } } } while (0)
struct XcdBarrier { unsigned* bar; unsigned x; volatile LAS unsigned* st; };
__device__ __forceinline__ XcdBarrier xcd_barrier_post(unsigned* bar, volatile LAS unsigned* st) {
    XcdBarrier b; b.bar = bar; b.x = xb_xcc_id(); b.st = st;
    if (threadIdx.x == 0) (void)xb_add(&bar[XB_XCNT(b.x)], 1u);
    return b;
}
__device__ __forceinline__ void xcd_barrier_complete(unsigned* bar, unsigned x, unsigned& nloc, unsigned& nx) {
    const unsigned G = gridDim.x * gridDim.y * gridDim.z;
    unsigned sum, cnt, mine, sp = 0u;
    for (;;) {
        sum = 0u; cnt = 0u; mine = 0u;
#pragma unroll
        for (unsigned j = 0; j < 16; ++j) { const unsigned c = xb_ld(&bar[XB_XCNT(j)]); sum += c; cnt += (c > 0u) ? 1u : 0u; mine = (j == x) ? c : mine; }
        if (sum == G) break;
        __builtin_amdgcn_s_sleep(1);
        if ((++sp & 255u) == 0u) { if (xb_ld(&bar[XB_TMO])) break; if (sp > XB_SPIN_CAP) { atomicAdd(&bar[XB_TMO], 1u); break; } }
    }
    nloc = mine > 0u ? mine : 1u; nx = cnt > 0u ? cnt : 1u;
}
__device__ __forceinline__ void xcd_barrier(const XcdBarrier& b) {
    asm volatile("s_waitcnt vmcnt(0)" ::: "memory");
    __syncthreads();
    if (threadIdx.x == 0) {
        unsigned* bar = b.bar;
        __builtin_amdgcn_s_waitcnt(0);
        unsigned nloc = b.st[0], nx = b.st[1];
        if (nloc == 0u) { xcd_barrier_complete(bar, b.x, nloc, nx); b.st[0] = nloc; b.st[1] = nx; }
        const unsigned old = xb_add(&bar[XB_XSUB(b.x)], 1u);
        const unsigned gen = old / nloc;
        if (old + 1u == (gen + 1u) * nloc) {
            __builtin_amdgcn_fence(__ATOMIC_RELEASE, "agent");
            asm volatile("s_waitcnt vmcnt(0)" ::: "memory");
            const unsigned og = xb_add(&bar[XB_TOP], 1u);
            const unsigned tg = og / nx;
            if (og + 1u == (tg + 1u) * nx) xb_add(&bar[XB_TOPGEN], 1u);
            else XB_SPIN(xb_ld(&bar[XB_TOPGEN]) == tg, bar);
            __builtin_amdgcn_fence(__ATOMIC_ACQUIRE, "agent");
            xb_add(&bar[XB_XGEN(b.x)], 1u);
            asm volatile("s_waitcnt vmcnt(0)" ::: "memory");
        } else {
            XB_SPIN(xb_ld(&bar[XB_XGEN(b.x)]) == gen, bar);
            __builtin_amdgcn_fence(__ATOMIC_ACQUIRE, "agent");
            asm volatile("s_waitcnt vmcnt(0)" ::: "memory");
        }
    }
    __syncthreads();
}

__global__ void __launch_bounds__(NTHREADS, 2) fwd_kernel(Args args) {
    extern __shared__ __attribute__((aligned(16))) unsigned char lds_raw[];
    LAS unsigned char* lds = (LAS unsigned char*)lds_raw;
    unsigned char* ws = args.ws;
    bf16_t* US = (bf16_t*)(ws + WS_US); bf16_t* XB = (bf16_t*)(ws + WS_US); float* R = (float*)(ws + WS_US);
    bf16_t* WIN = (bf16_t*)(ws + WS_WIN); bf16_t* WOUT = (bf16_t*)(ws + WS_WOUT); float* DEC = (float*)(ws + WS_DEC);
    bf16_t* H = (bf16_t*)(ws + WS_H); bf16_t* CAT = (bf16_t*)(ws + WS_CAT);
    const float* x = args.in[0]; const float* w_in = args.in[1]; const float* b_in = args.in[2]; const float* rpb = args.in[3];
    const float* lbf = args.in[4]; const float* lbb = args.in[5]; const float* hgain = args.in[6]; const float* w_out = args.in[7];
    const float* b_out = args.in[8]; const float* ln_g = args.in[9]; const float* ln_b = args.in[10];
    const int G = gridDim.x, bx = blockIdx.x;
    const int vcu = (G % 8 == 0) ? (bx % 8) * (G / 8) + bx / 8 : bx;
    const int lo = args.ph_lo, hi = args.ph_hi;
#define IN(k) (lo <= (k) && (k) < hi)
    volatile LAS unsigned* bst = (volatile LAS unsigned*)(lds + LDS_BYTES - 64);
    if (threadIdx.x == 0) { bst[0] = 0u; bst[1] = 0u; }
    __syncthreads();
    XcdBarrier bar; bar.bar = (unsigned*)(ws + WS_CTL); bar.x = 0; bar.st = bst;
    if (args.coop) bar = xcd_barrier_post((unsigned*)(ws + WS_CTL), bst);
#define SEAM(k) do { if (args.coop && IN(k) && IN((k) + 1)) xcd_barrier(bar); } while (0)
    if (IN(0)) p0_convert(x, w_in, w_out, XB, WIN, WOUT);
    SEAM(0);
    if (IN(1)) {
        pg8::Gemm gm{XB, WIN, MROWS, DIN, DM}; pg8::StaticOrder so; so.init(MROWS, DIN, G, vcu);
        EpiH ep{H, b_in};
        pg8::gemm_phase<EpiH, pg8::StaticOrder, true, true>(lds, gm, so, ep);
    }
    SEAM(1);
    if (IN(2)) {
#ifdef OLD_ATTN
        for (int at = bx; at < 1024; at += G) { const int a2 = (at % 256) * 4 + at / 256; attn_tile(lds, H, rpb, CAT, a2); }
#else
        attn_phase(lds, H, rpb, CAT, bx, G);
#endif
#ifndef NO_HG
#ifdef OLD_P2B
        if (args.pad == 0) for (int ht = bx; ht < 1024; ht += G) hgrn_local_tile(lds, H, lbf, lbb, US, DEC, ht);
#else
        if (args.pad == 0) hgrn_local_phase(lds, H, lbf, lbb, US, DEC, bx, G);
#endif
#endif
    }
    SEAM(2);
#ifdef OLD_P3
    if (IN(3)) hgrn_state_scan_old(US, DEC, args.pad);
#else
    if (IN(3)) hgrn_state_scan(US, DEC, args.pad);
#endif
    SEAM(3);
#ifdef OLD_P4
    if (IN(4)) { for (int ht = bx; ht < 1024; ht += G) hgrn_out_tile(lds, H, US, hgain, CAT, ht); }
#else
    if (IN(4)) hgrn_out_phase(H, US, hgain, CAT, bx, G);
#endif
    SEAM(4);
    if (IN(5)) {
        pg8::Gemm gm{CAT, WOUT, MROWS, DM, DM}; pg8::StaticOrder so; so.init(MROWS, DM, G, vcu);
        EpiR ep{R, b_out, x};
        pg8::gemm_phase<EpiR, pg8::StaticOrder, false, true>(lds, gm, so, ep);
    }
    SEAM(5);
    if (IN(6)) ln_rows(R, ln_g, ln_b, args.out);
#undef IN
#undef SEAM
}

extern "C" void kernel_launch(void* const* d_in, const int* in_sizes, int n_in, void* d_out, int out_size, void* d_ws, size_t ws_size, hipStream_t stream) {
    static int grid = 0;
    if (grid == 0) {
        int dev = 0, cus = 0, per_cu = 0;
        if (hipGetDevice(&dev) != hipSuccess || hipDeviceGetAttribute(&cus, hipDeviceAttributeMultiprocessorCount, dev) != hipSuccess) { fprintf(stderr, "kernel_launch: device query failed\n"); grid = -1; return; }
        if (hipFuncSetAttribute((const void*)fwd_kernel, hipFuncAttributeMaxDynamicSharedMemorySize, LDS_BYTES) != hipSuccess) { fprintf(stderr, "kernel_launch: hipFuncSetAttribute failed\n"); grid = -1; return; }
        if (hipOccupancyMaxActiveBlocksPerMultiprocessor(&per_cu, (const void*)fwd_kernel, NTHREADS, LDS_BYTES) != hipSuccess || per_cu < 1) { fprintf(stderr, "kernel_launch: occupancy query gave %d\n", per_cu); per_cu = 1; }
        (void)hipGetLastError();
        if (per_cu > 1) per_cu = 1;
        grid = cus * per_cu;
        if (ws_size < 256 * MiB) fprintf(stderr, "kernel_launch: workspace too small (%zu)\n", ws_size);
    }
    if (grid < 0) return;
    Args a{};
    for (int i = 0; i < 11; ++i) a.in[i] = (const float*)d_in[i];
    a.out = (float*)d_out; a.ws = (unsigned char*)d_ws;
#if MK_LAUNCHES == 1
    a.ph_lo = 0; a.ph_hi = 7; a.coop = 1;
    if (hipMemsetAsync((char*)d_ws + WS_CTL, 0, 16384, stream) != hipSuccess) { fprintf(stderr, "kernel_launch: memset failed\n"); return; }
    hipLaunchKernelGGL(fwd_kernel, dim3(grid), dim3(NTHREADS), LDS_BYTES, stream, a);
#else
    for (int p = 0; p < 7; ++p) {
        a.ph_lo = p; a.ph_hi = p + 1; a.coop = 0;
        int reps = 1;
#ifdef PROBE_PHASE
        if (p == PROBE_PHASE) reps = 1 + PROBE_N;
#endif
        for (int q = 0; q < reps; ++q) { a.pad = ((p == 2 || p == 3) && q + 1 < reps) ? 1 : 0; hipLaunchKernelGGL(fwd_kernel, dim3(grid), dim3(NTHREADS), LDS_BYTES, stream, a); }
    }
#endif
}
```
